# Optimizing an MI355X kernel written in HIP

```python
import jax, jax.numpy as jnp
from jax import lax
import numpy as np

D_MODEL = 2048
BATCH = 2
SEQ = 4096
DEPTH = 1

HEAD_DIM = 128
N_HEADS = D_MODEL // HEAD_DIM
N_HEADS_B = N_HEADS // 4
N_HEADS_A = N_HEADS - N_HEADS_B
DILATION_PATTERNS = ((128, 1), (512, 4), (2048, 16))
HEADS_PER_GROUP = N_HEADS_A // len(DILATION_PATTERNS)
WIDTH_A = HEADS_PER_GROUP * HEAD_DIM
WIDTH_B = N_HEADS_B * HEAD_DIM
GRID_W = 64
NA_ROWS = 8
NA_COLS = 16
D_FF = 4 * D_MODEL
N_BRANCHES = 2
BAND_BLOCK = 64
EPS = 1e-6
NEG = -1e30

kernel_name = "hybrid_dilated_neighbourhood_gated_encoder"


def _rmsnorm(x, g):
    xf = x.astype(jnp.float32)
    y = xf * lax.rsqrt(jnp.mean(xf * xf, axis=-1, keepdims=True) + EPS)
    return (y * g.astype(jnp.float32)).astype(x.dtype)


def _alibi_slopes(n):
    return jnp.asarray(2.0 ** (-8.0 * np.arange(1, n + 1) / n), dtype=jnp.float32)


def _banded_attention(q, k, v, slopes, half_window, stride):
    B, H, N, L, hd = q.shape
    Qb = BAND_BLOCK
    W = half_window
    nb = -(-L // Qb)
    Lp = nb * Qb
    Kb = Qb + 2 * W
    qp = jnp.pad(q, ((0, 0), (0, 0), (0, 0), (0, Lp - L), (0, 0)))
    kp = jnp.pad(k, ((0, 0), (0, 0), (0, 0), (W, Lp - L + W), (0, 0)))
    vp = jnp.pad(v, ((0, 0), (0, 0), (0, 0), (W, Lp - L + W), (0, 0)))
    key_idx = np.arange(nb)[:, None] * Qb + np.arange(Kb)[None, :]
    kb = jnp.take(kp, key_idx, axis=3)
    vb = jnp.take(vp, key_idx, axis=3)
    qb = qp.reshape(B, H, N, nb, Qb, hd)
    s = jnp.einsum('bhniqd,bhnikd->bhniqk', qb, kb).astype(jnp.float32) * (HEAD_DIM ** -0.5)
    qpos = np.arange(Lp).reshape(nb, Qb)
    kpos = key_idx - W
    rel = np.abs(kpos[:, None, :] - qpos[:, :, None])
    valid = (rel <= W) & (kpos >= 0)[:, None, :] & (kpos < L)[:, None, :]
    bias = -(slopes * stride)[:, None, None, None, None] * rel.astype(np.float32)[None, None]
    s = jnp.where(valid, s + bias, NEG)
    m = jnp.max(s, axis=-1, keepdims=True)
    p = jnp.exp(s - m)
    den = jnp.sum(p, axis=-1, keepdims=True)
    o = jnp.einsum('bhniqk,bhnikd->bhniqd', (p / den).astype(v.dtype), vb)
    lse = (m + jnp.log(den))[..., 0]
    o = o.reshape(B, H, N, Lp, hd)[:, :, :, :L]
    lse = lse.reshape(B, H, N, Lp)[:, :, :, :L]
    return o, lse


def _dilated_mixer(q, k, v):
    B, S = q.shape[0], q.shape[1]
    slopes = _alibi_slopes(N_HEADS_A)
    outs, lses = [], []
    for g, (window, d) in enumerate(DILATION_PATTERNS):
        hs = slice(g * HEADS_PER_GROUP, (g + 1) * HEADS_PER_GROUP)

        def to_residue(t):
            return t[:, :, hs].reshape(B, S // d, d, HEADS_PER_GROUP, HEAD_DIM).transpose(0, 3, 2, 1, 4)

        o, lse = _banded_attention(to_residue(q), to_residue(k), to_residue(v),
                                   slopes[hs], window // (2 * d), d)
        outs.append(o.transpose(0, 3, 2, 1, 4).reshape(B, S, HEADS_PER_GROUP, HEAD_DIM))
        lses.append(lse.transpose(0, 3, 2, 1).reshape(B, S, HEADS_PER_GROUP))
    o_all = jnp.stack(outs, axis=0).astype(jnp.float32)
    alpha = jax.nn.softmax(jnp.stack(lses, axis=0), axis=0)
    y = jnp.sum(alpha[..., None] * o_all, axis=0)
    return y.reshape(B, S, WIDTH_A).astype(q.dtype)


def _neighbourhood_mixer(q, k, v, rpb):
    B, S, H, hd = q.shape
    rows = S // GRID_W
    kh = min(NA_ROWS, rows)
    kw = NA_COLS

    def grid(t):
        return t.reshape(B, rows, GRID_W, H, hd).transpose(0, 3, 1, 2, 4)

    row_start = np.clip(np.arange(rows) - kh // 2, 0, rows - kh)
    row_idx = row_start[:, None] + np.arange(kh)[None, :]
    kg = jnp.take(grid(k), row_idx, axis=2).reshape(B, H, rows, kh * GRID_W, hd)
    vg = jnp.take(grid(v), row_idx, axis=2).reshape(B, H, rows, kh * GRID_W, hd)
    col = np.arange(GRID_W)
    col_start = np.clip(col - kw // 2, 0, GRID_W - kw)
    col_ok = (col[None, :] >= col_start[:, None]) & (col[None, :] < col_start[:, None] + kw)
    mask = np.tile(col_ok, (1, kh))
    dr = row_idx - np.arange(rows)[:, None]
    dc = np.clip(col[None, :] - col[:, None], -(kw - 1), kw - 1)
    bias = rpb.astype(jnp.float32)[:, dr + NA_ROWS - 1][..., dc + NA_COLS - 1]
    bias = bias.transpose(0, 1, 3, 2, 4).reshape(H, rows, GRID_W, kh * GRID_W)
    s = jnp.einsum('bhrqd,bhrkd->bhrqk', grid(q), kg).astype(jnp.float32) * (HEAD_DIM ** -0.5) + bias
    s = jnp.where(mask, s, NEG)
    p = jax.nn.softmax(s, axis=-1)
    o = jnp.einsum('bhrqk,bhrkd->bhrqd', p.astype(v.dtype), vg)
    return o.transpose(0, 2, 3, 1, 4).reshape(B, S, WIDTH_B)


def _mixer_block(h, w_qkv, w_gate, b_gate, rpb, w_proj_a, w_proj_b, w_out):
    B, S, _ = h.shape
    qkv = (h @ w_qkv).reshape(B, S, 3, N_HEADS, HEAD_DIM)
    q, k, v = qkv[:, :, 0], qkv[:, :, 1], qkv[:, :, 2]
    y_a = _dilated_mixer(q[:, :, :N_HEADS_A], k[:, :, :N_HEADS_A], v[:, :, :N_HEADS_A])
    y_b = _neighbourhood_mixer(q[:, :, N_HEADS_A:], k[:, :, N_HEADS_A:], v[:, :, N_HEADS_A:], rpb)
    gates = jax.nn.sigmoid(h @ w_gate + b_gate).reshape(B, S, N_BRANCHES, D_MODEL)
    merged = gates[:, :, 0] * (y_a @ w_proj_a) + gates[:, :, 1] * (y_b @ w_proj_b)
    return merged @ w_out


def _sqrelu_mlp(h, w_up, w_down):
    return jnp.square(jax.nn.relu(h @ w_up)) @ w_down


def setup_inputs(seed: int = 0) -> dict:
    key = jax.random.key(seed)
    ks = jax.random.split(key, 14)
    f32 = jnp.float32

    def nrm(k, shape, scale):
        return jax.random.normal(k, shape, f32) * scale

    return {
        "x": nrm(ks[0], (BATCH, SEQ, D_MODEL), 1.0),
        "norm_mix": 1.0 + nrm(ks[1], (DEPTH, D_MODEL), 0.02),
        "w_qkv": nrm(ks[2], (DEPTH, D_MODEL, 3 * N_HEADS * HEAD_DIM), D_MODEL ** -0.5),
        "w_gate": nrm(ks[3], (DEPTH, D_MODEL, N_BRANCHES * D_MODEL), D_MODEL ** -0.5),
        "b_gate": nrm(ks[4], (DEPTH, N_BRANCHES * D_MODEL), 0.02),
        "rpb": nrm(ks[5], (DEPTH, N_HEADS_B, 2 * NA_ROWS - 1, 2 * NA_COLS - 1), 0.1),
        "w_proj_a": nrm(ks[6], (DEPTH, WIDTH_A, D_MODEL), WIDTH_A ** -0.5),
        "w_proj_b": nrm(ks[7], (DEPTH, WIDTH_B, D_MODEL), WIDTH_B ** -0.5),
        "w_out": nrm(ks[8], (DEPTH, D_MODEL, D_MODEL), D_MODEL ** -0.5),
        "norm_mlp": 1.0 + nrm(ks[9], (DEPTH, D_MODEL), 0.02),
        "w_up": nrm(ks[10], (DEPTH, D_MODEL, D_FF), D_MODEL ** -0.5),
        "w_down": nrm(ks[11], (DEPTH, D_FF, D_MODEL), D_FF ** -0.5),
        "norm_final": 1.0 + nrm(ks[12], (D_MODEL,), 0.02),
    }


def reference(x, norm_mix, w_qkv, w_gate, b_gate, rpb, w_proj_a, w_proj_b, w_out,
              norm_mlp, w_up, w_down, norm_final):
    for l in range(DEPTH):
        h = _rmsnorm(x, norm_mix[l])
        x = x + _mixer_block(h, w_qkv[l], w_gate[l], b_gate[l], rpb[l],
                             w_proj_a[l], w_proj_b[l], w_out[l])
        h = _rmsnorm(x, norm_mlp[l])
        x = x + _sqrelu_mlp(h, w_up[l], w_down[l])
    return _rmsnorm(x, norm_final)
```

```cpp
#include <hip/hip_runtime.h>
#include <hip/hip_cooperative_groups.h>
#include <cstdio>
#include <cstdint>
namespace cg = cooperative_groups;
namespace pg8 {
#define PG8_LAS __attribute__((address_space(3)))
typedef unsigned short bf16_t;
typedef short bf16x8 __attribute__((ext_vector_type(8)));
typedef float f32x4 __attribute__((ext_vector_type(4)));
typedef unsigned u32x4 __attribute__((ext_vector_type(4)));
constexpr int BM = 256, BK = 64, HALF = 128, HTB = HALF * BK * 2  , STAGE_BYTES = 8 * HTB, NXCD = 8, WGM = 8;

__host__ __device__ __forceinline__ int lds_byte(int r, int c) { const int st = (r >> 4) * 2 + (c >> 5), rr = r & 15, cc = c & 31, ob = rr * 64 + cc * 2; return st * 1024 + (ob ^ (((ob >> 9) & 1) << 5)); }
__host__ __device__ __forceinline__ void stage_rc(int b, int& R, int& C) { const int st = b / 1024, sb = b % 1024, swz = sb ^ (((sb >> 9) & 1) << 5); R = (st >> 1) * 16 + swz / 64; C = (st & 1) * 32 + (swz % 64) / 2; }
__host__ __device__ __forceinline__ int perm32(int rho) { const int n = rho >> 4, i = rho & 15; return 8 * (i >> 2) + 4 * n + (i & 3); }

struct Unit { int pm, pn; };
struct Gemm { const bf16_t* A; const bf16_t* Bt; int M, N, K; };

struct StaticOrder {
    int nM, nN, nwg, G, c;
    __host__ __device__ void init(int M, int N, int G_, int c_) { nM = M / BM; nN = N / BM; nwg = nM * nN; G = G_; c = c_; }
    __host__ __device__ bool next(int i, Unit& u) const {
        const long L = (long)i * G + c; if (L >= nwg) return false;
        int wgid = (int)L; { const int q = nwg / NXCD, r = nwg % NXCD, xcd = wgid % NXCD, off = wgid / NXCD; wgid = (xcd < r ? xcd * (q + 1) : r * (q + 1) + (xcd - r) * q) + off; }
        const int nig = WGM * nN, gid = wgid / nig, fm = gid * WGM, gsz = (nM - fm) < WGM ? (nM - fm) : WGM;
        u.pm = fm + ((wgid % nig) % gsz); u.pn = (wgid % nig) / gsz; return true;
    }
    __device__ __forceinline__ void a_ready(const Unit&) const {}
    __device__ __forceinline__ void done(const Unit&) const {}
};
typedef __bf16 pg8_bf16x2 __attribute__((ext_vector_type(2)));
typedef float pg8_f32x2 __attribute__((ext_vector_type(2)));
__device__ __forceinline__ unsigned cvt_pk_bf16(float lo, float hi) { pg8_f32x2 v = {lo, hi}; pg8_bf16x2 b = __builtin_convertvector(v, pg8_bf16x2); return __builtin_bit_cast(unsigned, b); }
__device__ __forceinline__ u32x4 pack8(const f32x4 v0, const f32x4 v1) { u32x4 w; w.x = cvt_pk_bf16(v0[0], v0[1]); w.y = cvt_pk_bf16(v0[2], v0[3]); w.z = cvt_pk_bf16(v1[0], v1[1]); w.w = cvt_pk_bf16(v1[2], v1[3]); return w; }
__device__ __forceinline__ void unpack8(const u32x4 w, f32x4& v0, f32x4& v1) {
    v0[0] = __uint_as_float(w.x << 16); v0[1] = __uint_as_float(w.x & 0xffff0000u); v0[2] = __uint_as_float(w.y << 16); v0[3] = __uint_as_float(w.y & 0xffff0000u);
    v1[0] = __uint_as_float(w.z << 16); v1[1] = __uint_as_float(w.z & 0xffff0000u); v1[2] = __uint_as_float(w.w << 16); v1[3] = __uint_as_float(w.w & 0xffff0000u); }
__device__ __forceinline__ float sigmoidf_fast(float x) { return __builtin_amdgcn_rcpf(1.0f + __expf(-x)); }

struct EpiQkvGate {
    static constexpr bool PERM = true, AFTER_DRAIN = false;
    bf16_t* QKV; bf16_t* G; const float* bgate;
    __device__ __forceinline__ void operator()(const f32x4 (&acc)[2][2][4][2], const Unit& u, int wr, int wc, int fr, int fq) const {
        const int row0 = u.pm * BM + wr * 64 + fr, colt = u.pn * BM, cw = wc * 32 + 8 * fq;
        if (colt < 6144) {
#pragma unroll
            for (int ai = 0; ai < 2; ++ai)
#pragma unroll
                for (int m = 0; m < 4; ++m) { bf16_t* rowp = QKV + (size_t)(row0 + ai * HALF + m * 16) * 6144 + colt + cw;
#pragma unroll
                    for (int bj = 0; bj < 2; ++bj) *(u32x4*)(rowp + bj * HALF) = pack8(acc[ai][bj][m][0], acc[ai][bj][m][1]); }
        } else {
            const int gc = colt - 6144 + cw;
            f32x4 bv[2][2];
#pragma unroll
            for (int bj = 0; bj < 2; ++bj)
#pragma unroll
                for (int n = 0; n < 2; ++n) bv[bj][n] = *(const f32x4*)(bgate + gc + bj * HALF + 4 * n);
#pragma unroll
            for (int ai = 0; ai < 2; ++ai)
#pragma unroll
                for (int m = 0; m < 4; ++m) { bf16_t* rowp = G + (size_t)(row0 + ai * HALF + m * 16) * 4096 + gc;
#pragma unroll
                    for (int bj = 0; bj < 2; ++bj) { f32x4 v0 = acc[ai][bj][m][0] + bv[bj][0], v1 = acc[ai][bj][m][1] + bv[bj][1];
#pragma unroll
                        for (int e = 0; e < 4; ++e) { v0[e] = sigmoidf_fast(v0[e]); v1[e] = sigmoidf_fast(v1[e]); }
                        *(u32x4*)(rowp + bj * HALF) = pack8(v0, v1); } }
        }
    }
};
template <bool FIRST> struct EpiProj {
    static constexpr bool PERM = true, AFTER_DRAIN = false;
    const bf16_t* G; int goff; bf16_t* T; bf16_t* O;
    __device__ __forceinline__ void operator()(const f32x4 (&acc)[2][2][4][2], const Unit& u, int wr, int wc, int fr, int fq) const {
        const int row0 = u.pm * BM + wr * 64 + fr, col0 = u.pn * BM + wc * 32 + 8 * fq;
#pragma unroll
        for (int ai = 0; ai < 2; ++ai)
#pragma unroll
            for (int m = 0; m < 4; ++m) { const size_t row = (size_t)(row0 + ai * HALF + m * 16);
#pragma unroll
                for (int bj = 0; bj < 2; ++bj) { const int col = col0 + bj * HALF;
                    f32x4 g0, g1; unpack8(*(const u32x4*)(G + row * 4096 + goff + col), g0, g1);
                    f32x4 v0 = acc[ai][bj][m][0] * g0, v1 = acc[ai][bj][m][1] * g1;
                    if (!FIRST) { f32x4 t0, t1; unpack8(*(const u32x4*)(T + row * 2048 + col), t0, t1); v0 += t0; v1 += t1; }
                    *(u32x4*)((FIRST ? T : O) + row * 2048 + col) = pack8(v0, v1); } }
    }
};
struct EpiOut {
    static constexpr bool PERM = true, AFTER_DRAIN = false;
    const float* X; float* X1; bf16_t* XG; const float* gmlp; float* SS;
    __device__ __forceinline__ void operator()(const f32x4 (&acc)[2][2][4][2], const Unit& u, int wr, int wc, int fr, int fq) const {
        const int row0 = u.pm * BM + wr * 64 + fr, col0 = u.pn * BM + wc * 32 + 8 * fq;
        f32x4 gv[2][2];
#pragma unroll
        for (int bj = 0; bj < 2; ++bj)
#pragma unroll
            for (int n = 0; n < 2; ++n) gv[bj][n] = *(const f32x4*)(gmlp + col0 + bj * HALF + 4 * n);
#pragma unroll
        for (int ai = 0; ai < 2; ++ai)
#pragma unroll
            for (int m = 0; m < 4; ++m) { const size_t row = (size_t)(row0 + ai * HALF + m * 16); float ss = 0.f;
#pragma unroll
                for (int bj = 0; bj < 2; ++bj) { const size_t off = row * 2048 + col0 + bj * HALF;
                    const f32x4 x0 = *(const f32x4*)(X + off), x1 = *(const f32x4*)(X + off + 4);
                    const f32x4 v0 = acc[ai][bj][m][0] + x0, v1 = acc[ai][bj][m][1] + x1;
                    *(f32x4*)(X1 + off) = v0; *(f32x4*)(X1 + off + 4) = v1;
                    ss += (v0[0] * v0[0] + v0[1] * v0[1]) + (v0[2] * v0[2] + v0[3] * v0[3]) + (v1[0] * v1[0] + v1[1] * v1[1]) + (v1[2] * v1[2] + v1[3] * v1[3]);
                    *(u32x4*)(XG + off) = pack8(v0 * gv[bj][0], v1 * gv[bj][1]); }
                ss += __shfl_xor(ss, 16); ss += __shfl_xor(ss, 32);
                if (fq == 0) __hip_atomic_fetch_add(SS + row, ss, __ATOMIC_RELAXED, __HIP_MEMORY_SCOPE_AGENT); }
    }
};
struct EpiUp {
    static constexpr bool PERM = true, AFTER_DRAIN = false;
    bf16_t* H; const float* SS;
    __device__ __forceinline__ void operator()(const f32x4 (&acc)[2][2][4][2], const Unit& u, int wr, int wc, int fr, int fq) const {
        const int row0 = u.pm * BM + wr * 64 + fr, col0 = u.pn * BM + wc * 32 + 8 * fq;
#pragma unroll
        for (int ai = 0; ai < 2; ++ai)
#pragma unroll
            for (int m = 0; m < 4; ++m) { const size_t row = (size_t)(row0 + ai * HALF + m * 16);
                const float rs = __builtin_amdgcn_rsqf(__hip_atomic_load(SS + row, __ATOMIC_RELAXED, __HIP_MEMORY_SCOPE_AGENT) * (1.0f / 2048.0f) + 1e-6f);
#pragma unroll
                for (int bj = 0; bj < 2; ++bj) { f32x4 v0 = acc[ai][bj][m][0] * rs, v1 = acc[ai][bj][m][1] * rs;
#pragma unroll
                    for (int e = 0; e < 4; ++e) { const float a = fmaxf(v0[e], 0.f), b = fmaxf(v1[e], 0.f); v0[e] = a * a; v1[e] = b * b; }
                    *(u32x4*)(H + row * 8192 + col0 + bj * HALF) = pack8(v0, v1); } }
    }
};
struct EpiDown {
    static constexpr bool PERM = true, AFTER_DRAIN = false;
    float* X1; float* SS;
    __device__ __forceinline__ void operator()(const f32x4 (&acc)[2][2][4][2], const Unit& u, int wr, int wc, int fr, int fq) const {
        const int row0 = u.pm * BM + wr * 64 + fr, col0 = u.pn * BM + wc * 32 + 8 * fq;
#pragma unroll
        for (int ai = 0; ai < 2; ++ai)
#pragma unroll
            for (int m = 0; m < 4; ++m) { const size_t row = (size_t)(row0 + ai * HALF + m * 16); float ss = 0.f;
#pragma unroll
                for (int bj = 0; bj < 2; ++bj) { const size_t off = row * 2048 + col0 + bj * HALF;
                    const f32x4 x0 = *(const f32x4*)(X1 + off), x1 = *(const f32x4*)(X1 + off + 4);
                    const f32x4 v0 = acc[ai][bj][m][0] + x0, v1 = acc[ai][bj][m][1] + x1;
                    *(f32x4*)(X1 + off) = v0; *(f32x4*)(X1 + off + 4) = v1;
                    ss += (v0[0] * v0[0] + v0[1] * v0[1]) + (v0[2] * v0[2] + v0[3] * v0[3]) + (v1[0] * v1[0] + v1[1] * v1[1]) + (v1[2] * v1[2] + v1[3] * v1[3]); }
                ss += __shfl_xor(ss, 16); ss += __shfl_xor(ss, 32);
                if (fq == 0) __hip_atomic_fetch_add(SS + row, ss, __ATOMIC_RELAXED, __HIP_MEMORY_SCOPE_AGENT); }
    }
};
template <class Epi, class Sched, bool ALIGN_EPI = false, bool SP2 = false>
__device__ __forceinline__ void gemm_phase(PG8_LAS unsigned char* lds, const Gemm g, const Sched& S, const Epi& E) {
    const int tid = threadIdx.x, wid = __builtin_amdgcn_readfirstlane(tid >> 6), lane = tid & 63, wr = wid >> 2, wc = wid & 3, fr = lane & 15, fq = lane >> 4;
    const int K = g.K, nt = K / BK;
    unsigned voffA[2], voffB[2];
#pragma unroll
    for (int i = 0; i < 2; ++i) { int R, C; stage_rc(tid * 16 + i * 8192, R, C); const int Rb = Epi::PERM ? ((R & ~31) + perm32(R & 31)) : R;
        voffA[i] = (unsigned)(R * K + C) * 2u; voffB[i] = (unsigned)(Rb * K + C) * 2u; }
    const size_t kstep = (size_t)(BK * 2);
    const size_t hstep = (size_t)HALF * K * 2;
    const size_t tstep = 2 * hstep;
    const unsigned ldsw = (unsigned)wid * 1024u;
    const int aoff = lds_byte(wr * 64 + fr, fq * 8), boff = lds_byte(wc * 32 + fr, fq * 8);
#define PG8_SA(b, h) (((b) * 2 + (h)) * HTB)
#define PG8_SB(b, h) ((4 + (b) * 2 + (h)) * HTB)
#define PG8_STAGE(bufoff, gbase, voff) do { _Pragma("unroll") for (int _i = 0; _i < 2; ++_i) \
        __builtin_amdgcn_global_load_lds((const unsigned*)((const char*)(gbase) + (voff)[_i]), (PG8_LAS unsigned*)(lds + (bufoff) + ldsw + _i * 8192), 16, 0, 0); } while (0)
#define PG8_LDA(dst, b, h) do { _Pragma("unroll") for (int m = 0; m < 4; ++m) _Pragma("unroll") for (int k = 0; k < 2; ++k) dst[m][k] = *(const PG8_LAS bf16x8*)(lds + PG8_SA(b, h) + aoff + m * 2048 + k * 1024); } while (0)
#define PG8_LDB(dst, b, h) do { _Pragma("unroll") for (int n = 0; n < 2; ++n) _Pragma("unroll") for (int k = 0; k < 2; ++k) dst[n][k] = *(const PG8_LAS bf16x8*)(lds + PG8_SB(b, h) + boff + n * 2048 + k * 1024); } while (0)
#define PG8_MMA(ai, bj, At, Bt) do { __builtin_amdgcn_s_setprio(1); _Pragma("unroll") for (int m = 0; m < 4; ++m) _Pragma("unroll") for (int n = 0; n < 2; ++n) _Pragma("unroll") for (int k = 0; k < 2; ++k) \
        acc[ai][bj][m][n] = __builtin_amdgcn_mfma_f32_16x16x32_bf16(Bt[n][k], At[m][k], acc[ai][bj][m][n], 0, 0, 0); __builtin_amdgcn_s_setprio(0); } while (0)
#define PG8_WAIT_V(n) asm volatile("s_waitcnt vmcnt(" #n ")" ::: "memory")
#define PG8_WAIT_L(n) asm volatile("s_waitcnt lgkmcnt(" #n ")" ::: "memory")
#define PG8_BAR __builtin_amdgcn_s_barrier()
#define PG8_SCHED __builtin_amdgcn_sched_barrier(0)
    Unit cur, nxt; int ui = 0;
    if (!S.next(0, cur)) return;
    f32x4 acc[2][2][4][2];
#pragma unroll
    for (int a = 0; a < 2; ++a)
#pragma unroll
        for (int b = 0; b < 2; ++b)
#pragma unroll
            for (int m = 0; m < 4; ++m)
#pragma unroll
                for (int n = 0; n < 2; ++n) acc[a][b][m][n] = (f32x4){0.f, 0.f, 0.f, 0.f};
    bf16x8 At[4][2], B0[2][2], B1[2][2];
    const char* cA = (const char*)g.A + (size_t)cur.pm * tstep; const char* cB = (const char*)g.Bt + (size_t)cur.pn * tstep;
    S.a_ready(cur);
    if constexpr (SP2) {
        PG8_STAGE(PG8_SB(0, 0), cB, voffB); PG8_STAGE(PG8_SB(0, 1), cB + hstep, voffB); PG8_STAGE(PG8_SA(0, 0), cA, voffA); PG8_STAGE(PG8_SA(0, 1), cA + hstep, voffA);
        if (wr == 1) PG8_BAR;
        PG8_WAIT_V(2); PG8_BAR;
        PG8_STAGE(PG8_SB(1, 0), cB + kstep, voffB); PG8_STAGE(PG8_SA(1, 0), cA + kstep, voffA); PG8_STAGE(PG8_SB(1, 1), cB + hstep + kstep, voffB);
        PG8_WAIT_V(6); PG8_BAR;
    } else {
        PG8_STAGE(PG8_SB(0, 0), cB, voffB); PG8_STAGE(PG8_SA(0, 0), cA, voffA); PG8_STAGE(PG8_SB(0, 1), cB + hstep, voffB); PG8_STAGE(PG8_SA(0, 1), cA + hstep, voffA);
        if (wr == 1) PG8_BAR;
        PG8_WAIT_V(4); PG8_BAR;
        PG8_STAGE(PG8_SB(1, 0), cB + kstep, voffB); PG8_STAGE(PG8_SA(1, 0), cA + kstep, voffA); PG8_STAGE(PG8_SB(1, 1), cB + hstep + kstep, voffB);
        PG8_WAIT_V(6); PG8_BAR;
    }
    for (;;) {
        const bool has_next = S.next(ui + 1, nxt);
        const char* nA = has_next ? (const char*)g.A + (size_t)nxt.pm * tstep : cA; const char* nB = has_next ? (const char*)g.Bt + (size_t)nxt.pn * tstep : cB;
        for (int t = 0; t < nt; t += 2) {
            const bool last = (t == nt - 2);
            const char* a1 = cA + (size_t)(t + 1) * kstep;
            const char* a2 = last ? nA : cA + (size_t)(t + 2) * kstep; const char* b2 = last ? nB : cB + (size_t)(t + 2) * kstep;
            const char* a3 = a2 + kstep; const char* b3 = b2 + kstep;
            if (last && has_next) S.a_ready(nxt);
            if constexpr (SP2) {
            PG8_LDB(B0, 0, 0); PG8_LDB(B1, 0, 1); PG8_SCHED; PG8_LDA(At, 0, 0); PG8_STAGE(PG8_SA(1, 1), a1 + hstep, voffA);
            PG8_WAIT_V(8); PG8_WAIT_L(0); PG8_BAR; PG8_MMA(0, 0, At, B0); PG8_MMA(0, 1, At, B1); PG8_BAR; PG8_SCHED;
            PG8_LDA(At, 0, 1); PG8_STAGE(PG8_SB(0, 0), b2, voffB); PG8_STAGE(PG8_SB(0, 1), b2 + hstep, voffB); PG8_STAGE(PG8_SA(0, 0), a2, voffA);
            PG8_WAIT_V(8); PG8_WAIT_L(0); PG8_BAR; PG8_MMA(1, 0, At, B0); PG8_MMA(1, 1, At, B1); PG8_BAR; PG8_SCHED;
            PG8_LDB(B0, 1, 0); PG8_LDB(B1, 1, 1); PG8_SCHED; PG8_LDA(At, 1, 0); PG8_STAGE(PG8_SA(0, 1), a2 + hstep, voffA);
            PG8_WAIT_V(8); PG8_WAIT_L(0); PG8_BAR; PG8_MMA(0, 0, At, B0); PG8_MMA(0, 1, At, B1); PG8_BAR; PG8_SCHED;
            PG8_LDA(At, 1, 1); PG8_STAGE(PG8_SB(1, 0), b3, voffB); PG8_STAGE(PG8_SB(1, 1), b3 + hstep, voffB); PG8_STAGE(PG8_SA(1, 0), a3, voffA);
            PG8_WAIT_V(8); PG8_WAIT_L(0); PG8_BAR; PG8_MMA(1, 0, At, B0); PG8_MMA(1, 1, At, B1); PG8_BAR; PG8_SCHED;
            } else {
            PG8_LDB(B0, 0, 0); PG8_SCHED; PG8_LDA(At, 0, 0); PG8_STAGE(PG8_SA(1, 1), a1 + hstep, voffA);
            PG8_WAIT_L(8); PG8_BAR; PG8_WAIT_L(0); PG8_MMA(0, 0, At, B0); PG8_BAR; PG8_SCHED;
            PG8_LDB(B1, 0, 1); PG8_STAGE(PG8_SB(0, 0), b2, voffB);
            PG8_BAR; PG8_WAIT_L(0); PG8_MMA(0, 1, At, B1); PG8_BAR;
            PG8_LDA(At, 0, 1); PG8_STAGE(PG8_SA(0, 0), a2, voffA);
            PG8_BAR; PG8_WAIT_L(0); PG8_MMA(1, 0, At, B0); PG8_BAR; PG8_SCHED;
            PG8_STAGE(PG8_SB(0, 1), b2 + hstep, voffB);
            PG8_WAIT_V(6); PG8_BAR; PG8_MMA(1, 1, At, B1); PG8_BAR;
            PG8_LDB(B0, 1, 0); PG8_SCHED; PG8_LDA(At, 1, 0); PG8_STAGE(PG8_SA(0, 1), a2 + hstep, voffA);
            PG8_WAIT_L(8); PG8_BAR; PG8_WAIT_L(0); PG8_MMA(0, 0, At, B0); PG8_BAR; PG8_SCHED;
            PG8_LDB(B1, 1, 1); PG8_STAGE(PG8_SB(1, 0), b3, voffB);
            PG8_BAR; PG8_WAIT_L(0); PG8_MMA(0, 1, At, B1); PG8_BAR;
            PG8_LDA(At, 1, 1); PG8_STAGE(PG8_SA(1, 0), a3, voffA);
            PG8_BAR; PG8_WAIT_L(0); PG8_MMA(1, 0, At, B0); PG8_BAR; PG8_SCHED;
            PG8_STAGE(PG8_SB(1, 1), b3 + hstep, voffB);
            PG8_WAIT_V(6); PG8_BAR; PG8_MMA(1, 1, At, B1); PG8_BAR;
            }
        }
        if constexpr (ALIGN_EPI) { if (wr == 0) PG8_BAR; }
        if constexpr (!Epi::AFTER_DRAIN) { E(acc, cur, wr, wc, fr, fq); S.done(cur); }
        if (!has_next) break;
#pragma unroll
        for (int a = 0; a < 2; ++a)
#pragma unroll
            for (int b = 0; b < 2; ++b)
#pragma unroll
                for (int m = 0; m < 4; ++m)
#pragma unroll
                    for (int n = 0; n < 2; ++n) acc[a][b][m][n] = (f32x4){0.f, 0.f, 0.f, 0.f};
        cur = nxt; cA = nA; cB = nB; ++ui;
        if constexpr (ALIGN_EPI) { if (wr == 1) PG8_BAR; }
    }
    PG8_WAIT_V(0);
    if constexpr (!ALIGN_EPI) { if (wr == 0) PG8_BAR; }
    PG8_BAR;
    if constexpr (Epi::AFTER_DRAIN) { E.fused(acc, cur, wr, wc, fr, fq, lds, wid, lane); S.done(cur); }
#undef PG8_SA
#undef PG8_SB
#undef PG8_STAGE
#undef PG8_LDA
#undef PG8_LDB
#undef PG8_MMA
#undef PG8_WAIT_V
#undef PG8_WAIT_L
#undef PG8_BAR
#undef PG8_SCHED
}
}

constexpr int NWAVES = 8;
constexpr int SEQ = 4096, DM = 2048, M = 2 * SEQ, NQKV = 6144, NG = 4096, N1 = NQKV + NG, DFF = 8192, WA = 512;
constexpr float EPS = 1e-6f, LOG2E = 1.4426950408889634f;
constexpr size_t MiB = 1u << 20;
constexpr size_t WS_SS1 = 0, WS_SS2 = 32768, WS_LSE = 65536;
constexpr size_t WS_WPA = 1 * MiB, WS_WPB = 3 * MiB, WS_WOUT = 5 * MiB;
constexpr size_t WS_YA = 13 * MiB, WS_YB = 21 * MiB;
constexpr size_t WS_RA = 29 * MiB;
constexpr size_t WS_H = WS_RA, WS_W1T = WS_RA + 32 * MiB, WS_WUPT = WS_RA, WS_WDNT = WS_RA + 32 * MiB;
constexpr size_t WS_RB = 101 * MiB;
constexpr size_t WS_QKV = WS_RB, WS_G = WS_RB + 96 * MiB;
constexpr size_t WS_T = WS_RB, WS_MG = WS_RB + 32 * MiB;
constexpr size_t WS_HM = WS_RB;
constexpr size_t WS_XG2 = WS_RB + 128 * MiB;
constexpr size_t WS_END = WS_RB + 160 * MiB;

constexpr size_t WS_CTL = 512 * 1024, CTL_ZERO_BYTES = 16384;
constexpr int MISC_OFF = 131072;
constexpr int LDS_BYTES = 131072 + 1024;

#define LAS __attribute__((address_space(3)))
typedef unsigned short bf16;
typedef unsigned v4u __attribute__((ext_vector_type(4)));
typedef unsigned v2u __attribute__((ext_vector_type(2)));
typedef float f32x4 __attribute__((ext_vector_type(4)));
typedef float f32x16 __attribute__((ext_vector_type(16)));
typedef short bf16x8 __attribute__((ext_vector_type(8)));
#define LDS_WAIT() asm volatile("s_waitcnt lgkmcnt(0)" ::: "memory")
__device__ __forceinline__ unsigned f2bf(float f) { unsigned u = __builtin_bit_cast(unsigned, f); return (u + 0x7fffu + ((u >> 16) & 1u)) >> 16; }
__device__ __forceinline__ unsigned pk2(float lo, float hi) { return f2bf(lo) | (f2bf(hi) << 16); }
__device__ __forceinline__ float bflo(unsigned w) { return __uint_as_float(w << 16); }
__device__ __forceinline__ float bfhi(unsigned w) { return __uint_as_float(w & 0xffff0000u); }
__device__ __forceinline__ float wave_sum(float v) {
#pragma unroll
    for (int o = 1; o < 64; o <<= 1) v += __shfl_xor(v, o);
    return v;
}

struct Frame {
    LAS unsigned char* lds;
    int tid, lane, wave, G, gw, ngw;
    const float *x, *norm_mix, *w_qkv, *w_gate, *b_gate, *rpb, *w_pa, *w_pb, *w_out, *norm_mlp, *w_up, *w_down, *norm_final;
    float* out; unsigned char* ws;
};

__device__ __forceinline__ void transpose_item(const float* W, int K, int N, bf16* WT, int row_off, LAS float* scr, int item, int lane) {
    const int nblk = N / 32, kb = item / nblk, nb = item % nblk, k0 = 64 * kb, n0 = 32 * nb;
#pragma unroll 8
    for (int i = 0; i < 32; ++i) { const int kk = 2 * i + (lane >> 5); scr[kk * 33 + (lane & 31)] = W[(size_t)(k0 + kk) * N + n0 + (lane & 31)]; }
    LDS_WAIT(); asm volatile("" ::: "memory");
    const int c = lane & 7;
#pragma unroll
    for (int j = 0; j < 4; ++j) { const int n = (lane >> 3) + 8 * j; const LAS float* s = scr + (8 * c) * 33 + n;
        v4u o; o.x = pk2(s[0 * 33], s[1 * 33]); o.y = pk2(s[2 * 33], s[3 * 33]); o.z = pk2(s[4 * 33], s[5 * 33]); o.w = pk2(s[6 * 33], s[7 * 33]);
        *(v4u*)(WT + (size_t)(row_off + n0 + n) * K + k0 + 8 * c) = o; }
    LDS_WAIT(); asm volatile("" ::: "memory");
}

__device__ __forceinline__ void p0_prologue(Frame& F) {
    LAS float* scr = (LAS float*)(F.lds + F.wave * 16384);
    bf16* W1t = (bf16*)(F.ws + WS_W1T);
    constexpr int I_QKV = (DM / 64) * (NQKV / 32), I_G = (DM / 64) * (NG / 32), I_P = (WA / 64) * (DM / 32), I_O = (DM / 64) * (DM / 32);
    constexpr int NITEMS = I_QKV + I_G + 2 * I_P + I_O;
    for (int it = F.gw; it < NITEMS; it += F.ngw) {
        int r = it;
        if (r < I_QKV) { transpose_item(F.w_qkv, DM, NQKV, W1t, 0, scr, r, F.lane); continue; } r -= I_QKV;
        if (r < I_G) { transpose_item(F.w_gate, DM, NG, W1t, NQKV, scr, r, F.lane); continue; } r -= I_G;
        if (r < I_P) { transpose_item(F.w_pa, WA, DM, (bf16*)(F.ws + WS_WPA), 0, scr, r, F.lane); continue; } r -= I_P;
        if (r < I_P) { transpose_item(F.w_pb, WA, DM, (bf16*)(F.ws + WS_WPB), 0, scr, r, F.lane); continue; } r -= I_P;
        transpose_item(F.w_out, DM, DM, (bf16*)(F.ws + WS_WOUT), 0, scr, r, F.lane);
    }
    bf16* H = (bf16*)(F.ws + WS_H);
    for (int m = F.gw; m < M; m += F.ngw) {
        const f32x4* xr = (const f32x4*)(F.x + (size_t)m * DM) + F.lane;
        f32x4 v[8]; float s = 0.f;
#pragma unroll
        for (int j = 0; j < 8; ++j) { v[j] = xr[64 * j]; s += (v[j].x * v[j].x + v[j].y * v[j].y) + (v[j].z * v[j].z + v[j].w * v[j].w); }
        const float rstd = 1.0f / sqrtf(wave_sum(s) * (1.0f / DM) + EPS);
        v2u* o8 = (v2u*)(H + (size_t)m * DM) + F.lane;
#pragma unroll
        for (int j = 0; j < 8; ++j) { const f32x4 g = ((const f32x4*)F.norm_mix)[F.lane + 64 * j]; v2u o; o.x = pk2(v[j].x * rstd * g.x, v[j].y * rstd * g.y); o.y = pk2(v[j].z * rstd * g.z, v[j].w * rstd * g.w); o8[64 * j] = o; }
    }
    float* ss = (float*)(F.ws + WS_SS1);
    for (int i = blockIdx.x * 512 + F.tid; i < 16384; i += F.G * 512) ss[i] = 0.f;
}

__device__ __forceinline__ void convert_updown(Frame& F) {
    LAS float* scr = (LAS float*)(F.lds + F.wave * 16384);
    constexpr int I_U = (DM / 64) * (DFF / 32), I_D = (DFF / 64) * (DM / 32);
    for (int it = F.gw; it < I_U + I_D; it += F.ngw) {
        if (it < I_U) transpose_item(F.w_up, DM, DFF, (bf16*)(F.ws + WS_WUPT), 0, scr, it, F.lane);
        else transpose_item(F.w_down, DFF, DM, (bf16*)(F.ws + WS_WDNT), 0, scr, it - I_U, F.lane);
    }
}

#define MFMA32(a, b, c) __builtin_amdgcn_mfma_f32_32x32x16_bf16((a), (b), (c), 0, 0, 0)
constexpr int VT_PITCH = 80;
constexpr float NEGF = -1e30f;
typedef __bf16 bf16x2_t __attribute__((ext_vector_type(2)));
typedef float f32x2_t __attribute__((ext_vector_type(2)));
__device__ __forceinline__ unsigned cvtpk(float lo, float hi) { f32x2_t v = {lo, hi}; bf16x2_t b = __builtin_convertvector(v, bf16x2_t); return __builtin_bit_cast(unsigned, b); }

struct AttnAcc { f32x16 o[4]; float m, l; };

__device__ __forceinline__ void attn_tile_update(AttnAcc& A, const f32x16& s2, const bf16* QKV, size_t vrow, int vcol, LAS unsigned char* vt, int lane) {
    const int key = lane & 31, dh = lane >> 5, hi = lane >> 5;
    v4u vv[8];
#pragma unroll
    for (int c = 0; c < 8; ++c) vv[c] = *(const v4u*)(QKV + vrow * NQKV + vcol + 8 * c);
    float tmax = s2[0];
#pragma unroll
    for (int r = 1; r < 16; ++r) tmax = fmaxf(tmax, s2[r]);
    tmax = fmaxf(tmax, __shfl_xor(tmax, 32));
    const float mnew = fmaxf(A.m, tmax);
    const float alpha = __builtin_amdgcn_exp2f(A.m - mnew);
    A.m = mnew;
    float p[16]; float ps = 0.f;
#pragma unroll
    for (int r = 0; r < 16; ++r) { p[r] = (s2[r] > -1e29f) ? __builtin_amdgcn_exp2f(s2[r] - mnew) : 0.f; ps += p[r]; }
    A.l = A.l * alpha + ps;
#pragma unroll
    for (int dt = 0; dt < 4; ++dt) A.o[dt] = A.o[dt] * alpha;
    bf16x8 pf[2];
#pragma unroll
    for (int s = 0; s < 2; ++s) { v4u w; w.x = cvtpk(p[8 * s + 0], p[8 * s + 1]); w.y = cvtpk(p[8 * s + 2], p[8 * s + 3]); w.z = cvtpk(p[8 * s + 4], p[8 * s + 5]); w.w = cvtpk(p[8 * s + 6], p[8 * s + 7]); pf[s] = __builtin_bit_cast(bf16x8, w); }
    LAS unsigned short* vw = (LAS unsigned short*)(vt + (64 * dh) * VT_PITCH + key * 2);
#pragma unroll
    for (int c = 0; c < 8; ++c) {
        const unsigned w0 = vv[c].x, w1 = vv[c].y, w2 = vv[c].z, w3 = vv[c].w;
        vw[((8 * c + 0) * VT_PITCH) / 2] = (unsigned short)(w0 & 0xffffu); vw[((8 * c + 1) * VT_PITCH) / 2] = (unsigned short)(w0 >> 16);
        vw[((8 * c + 2) * VT_PITCH) / 2] = (unsigned short)(w1 & 0xffffu); vw[((8 * c + 3) * VT_PITCH) / 2] = (unsigned short)(w1 >> 16);
        vw[((8 * c + 4) * VT_PITCH) / 2] = (unsigned short)(w2 & 0xffffu); vw[((8 * c + 5) * VT_PITCH) / 2] = (unsigned short)(w2 >> 16);
        vw[((8 * c + 6) * VT_PITCH) / 2] = (unsigned short)(w3 & 0xffffu); vw[((8 * c + 7) * VT_PITCH) / 2] = (unsigned short)(w3 >> 16);
    }
    LDS_WAIT();
    const LAS unsigned char* vr = vt + (lane & 31) * VT_PITCH + 16 * hi;
#pragma unroll
    for (int dt = 0; dt < 4; ++dt)
#pragma unroll
        for (int s = 0; s < 2; ++s) { const bf16x8 vf = *(const LAS bf16x8*)(vr + (32 * dt) * VT_PITCH + 32 * s); A.o[dt] = MFMA32(vf, pf[s], A.o[dt]); }
    LDS_WAIT();
}
__device__ __forceinline__ f32x16 attn_qk(const bf16* kp, const bf16x8 (&qf)[8]) {
    f32x16 s;
#pragma unroll
    for (int r = 0; r < 16; ++r) s[r] = 0.f;
#pragma unroll
    for (int st = 0; st < 8; ++st) { const bf16x8 kf = *(const bf16x8*)(kp + 16 * st); s = MFMA32(kf, qf[st], s); }
    return s;
}
__device__ __forceinline__ int pi32(int m) { return (m & 0x13) | ((m & 4) << 1) | ((m & 8) >> 1); }
__device__ __forceinline__ void attn_init(AttnAcc& A) {
#pragma unroll
    for (int dt = 0; dt < 4; ++dt)
#pragma unroll
        for (int r = 0; r < 16; ++r) A.o[dt][r] = 0.f;
    A.m = NEGF; A.l = 0.f;
}
__device__ __forceinline__ float attn_finish(AttnAcc& A, bf16* dst, size_t rowoff  , int lane) {
    const int hi = lane >> 5;
    const float lt = A.l + __shfl_xor(A.l, 32);
    const float inv = 1.0f / lt;
#pragma unroll
    for (int dt = 0; dt < 4; ++dt)
#pragma unroll
        for (int g4 = 0; g4 < 4; ++g4) { v2u w; w.x = cvtpk(A.o[dt][4 * g4 + 0] * inv, A.o[dt][4 * g4 + 1] * inv); w.y = cvtpk(A.o[dt][4 * g4 + 2] * inv, A.o[dt][4 * g4 + 3] * inv);
            *(v2u*)(dst + rowoff + 32 * dt + 8 * g4 + 4 * hi) = w; }
    return A.m + __builtin_amdgcn_logf(lt);
}

__device__ __forceinline__ void attn_unit_a(Frame& F, int ua, LAS unsigned char* vt) {
    bf16* QKV = (bf16*)(F.ws + WS_QKV); float* LSE = (float*)(F.ws + WS_LSE);
    const int lane = F.lane, q = lane & 31, hi = lane >> 5;
    const int b = ua / 1536, rem = ua % 1536, h = rem >> 7, idx = rem & 127, g = h >> 2, dsh = 2 * g, d = 1 << dsh, tpr = 128 >> dsh, L = SEQ >> dsh;
    const int r = idx / tpr, i0 = (idx % tpr) * 32;
    const float slope2 = exp2f(-8.0f * (float)(h + 1) / 12.0f) * (float)d * LOG2E;
    const float c1 = 0.08838834764831845f * LOG2E;
    const int iq = i0 + q;
    const size_t qrow = (size_t)b * SEQ + (size_t)iq * d + r;
    bf16x8 qf[8];
#pragma unroll
    for (int st = 0; st < 8; ++st) qf[st] = *(const bf16x8*)(QKV + qrow * NQKV + h * 128 + 16 * st + 8 * hi);
    AttnAcc A; attn_init(A);
    const int jbase = i0 - 64;
    for (int t = 0; t < 5; ++t) {
        int jk = jbase + 32 * t + pi32(q); jk = jk < 0 ? 0 : (jk > L - 1 ? L - 1 : jk);
        const size_t krow = (size_t)b * SEQ + (size_t)jk * d + r;
        f32x16 s = attn_qk(QKV + krow * NQKV + 2048 + h * 128 + 8 * hi, qf);
        f32x16 s2;
#pragma unroll
        for (int rr = 0; rr < 16; ++rr) { const int j = jbase + 32 * t + 16 * (rr >> 3) + 8 * hi + (rr & 7); const int rel = j - iq, arel = rel < 0 ? -rel : rel;
            const bool valid = (arel <= 64) && (j >= 0) && (j < L);
            s2[rr] = valid ? (s[rr] * c1 - slope2 * (float)arel) : NEGF; }
        int jv = jbase + 32 * t + q; jv = jv < 0 ? 0 : (jv > L - 1 ? L - 1 : jv);
        const size_t vrow = (size_t)b * SEQ + (size_t)jv * d + r;
        attn_tile_update(A, s2, QKV, vrow, 4096 + h * 128 + 64 * hi, vt, lane);
    }
    const float lse2 = attn_finish(A, QKV, qrow * NQKV + h * 128, lane);
    if (hi == 0) LSE[qrow * 12 + h] = lse2;
}
__device__ __forceinline__ void attn_unit_b(Frame& F, int ub, LAS unsigned char* vt) {
    bf16* QKV = (bf16*)(F.ws + WS_QKV); bf16* YB = (bf16*)(F.ws + WS_YB);
    const int lane = F.lane, q = lane & 31, hi = lane >> 5;
    const int b = ub / 512, rem = ub % 512, hb = rem >> 7, rem2 = rem & 127, R = rem2 >> 1, half = rem2 & 1, h = 12 + hb;
    const float c1 = 0.08838834764831845f * LOG2E;
    const int cq = 32 * half + q;
    const size_t qrow = (size_t)b * SEQ + R * 64 + cq;
    int rs = R - 4; rs = rs < 0 ? 0 : (rs > 56 ? 56 : rs);
    int cs = cq - 8; cs = cs < 0 ? 0 : (cs > 48 ? 48 : cs);
    bf16x8 qf[8];
#pragma unroll
    for (int st = 0; st < 8; ++st) qf[st] = *(const bf16x8*)(QKV + qrow * NQKV + h * 128 + 16 * st + 8 * hi);
    AttnAcc A; attn_init(A);
    const float* rp = F.rpb + hb * (15 * 31);
    for (int t = 0; t < 16; ++t) {
        const int Rk = rs + (t >> 1), cb = 32 * (t & 1);
        const size_t krow = (size_t)b * SEQ + Rk * 64 + cb + pi32(q);
        f32x16 s = attn_qk(QKV + krow * NQKV + 2048 + h * 128 + 8 * hi, qf);
        const float* rpr = rp + (Rk - R + 7) * 31;
        f32x16 s2;
#pragma unroll
        for (int rr = 0; rr < 16; ++rr) { const int col = cb + 16 * (rr >> 3) + 8 * hi + (rr & 7);
            const bool valid = (col >= cs) && (col < cs + 16);
            int di = col - cq + 15; di = di < 0 ? 0 : (di > 30 ? 30 : di);
            const float bias = rpr[di];
            s2[rr] = valid ? (s[rr] * c1 + bias * LOG2E) : NEGF; }
        const size_t vrow = (size_t)b * SEQ + Rk * 64 + cb + q;
        attn_tile_update(A, s2, QKV, vrow, 4096 + h * 128 + 64 * hi, vt, lane);
    }
    (void)attn_finish(A, YB, qrow * 512 + hb * 128, lane);
}
__device__ __forceinline__ void attn_phase(Frame& F) {
    LAS unsigned char* vt = F.lds + F.wave * 16384;
    for (int su = F.gw; su < 2048; su += F.ngw) {
        if (su < 1024) attn_unit_b(F, su, vt);
        else { const int a0 = 3 * (su - 1024); for (int k = 0; k < 3; ++k) attn_unit_a(F, a0 + k, vt); }
    }
}
__device__ __forceinline__ void combine_phase(Frame& F) {
    const bf16* QKV = (const bf16*)(F.ws + WS_QKV); const float* LSE = (const float*)(F.ws + WS_LSE); bf16* YA = (bf16*)(F.ws + WS_YA);
    const int hg = F.lane >> 4, dc = (F.lane & 15) * 8;
    for (int m = F.gw; m < M; m += F.ngw) {
        const float l0 = LSE[(size_t)m * 12 + hg], l1 = LSE[(size_t)m * 12 + 4 + hg], l2 = LSE[(size_t)m * 12 + 8 + hg];
        const float mx = fmaxf(l0, fmaxf(l1, l2));
        float w0 = __builtin_amdgcn_exp2f(l0 - mx), w1 = __builtin_amdgcn_exp2f(l1 - mx), w2 = __builtin_amdgcn_exp2f(l2 - mx);
        const float inv = 1.0f / (w0 + w1 + w2); w0 *= inv; w1 *= inv; w2 *= inv;
        const v4u a = *(const v4u*)(QKV + (size_t)m * NQKV + (0 + hg) * 128 + dc), bq = *(const v4u*)(QKV + (size_t)m * NQKV + (4 + hg) * 128 + dc), c = *(const v4u*)(QKV + (size_t)m * NQKV + (8 + hg) * 128 + dc);
        v4u o;
        o.x = pk2(w0 * bflo(a.x) + w1 * bflo(bq.x) + w2 * bflo(c.x), w0 * bfhi(a.x) + w1 * bfhi(bq.x) + w2 * bfhi(c.x));
        o.y = pk2(w0 * bflo(a.y) + w1 * bflo(bq.y) + w2 * bflo(c.y), w0 * bfhi(a.y) + w1 * bfhi(bq.y) + w2 * bfhi(c.y));
        o.z = pk2(w0 * bflo(a.z) + w1 * bflo(bq.z) + w2 * bflo(c.z), w0 * bfhi(a.z) + w1 * bfhi(bq.z) + w2 * bfhi(c.z));
        o.w = pk2(w0 * bflo(a.w) + w1 * bflo(bq.w) + w2 * bflo(c.w), w0 * bfhi(a.w) + w1 * bfhi(bq.w) + w2 * bfhi(c.w));
        *(v4u*)(YA + (size_t)m * 512 + hg * 128 + dc) = o;
    }
}
__device__ __forceinline__ void final_phase(Frame& F) {
    const float* SS2 = (const float*)(F.ws + WS_SS2);
    for (int m = F.gw; m < M; m += F.ngw) {
        const float rstd = 1.0f / sqrtf(__hip_atomic_load(SS2 + m, __ATOMIC_RELAXED, __HIP_MEMORY_SCOPE_AGENT) * (1.0f / DM) + EPS);
        f32x4* xr = (f32x4*)(F.out + (size_t)m * DM) + F.lane;
#pragma unroll
        for (int j = 0; j < 8; ++j) { const f32x4 g = ((const f32x4*)F.norm_final)[F.lane + 64 * j]; f32x4 v = xr[64 * j]; v = v * rstd * g; xr[64 * j] = v; }
    }
}

#define GAS __attribute__((address_space(1)))
#define XB_TMO      128
#define XB_XCNT(j)  (256  + 64 * (j))
#define XB_XSUB(j)  (1280 + 64 * (j))
#define XB_XGEN(j)  (2304 + 64 * (j))
#define XB_TOP      3328
#define XB_TOPGEN   3392
#define XCD_BAR_WORDS 3456
#define XB_SPIN_CAP (1u << 18)

__device__ __forceinline__ unsigned xb_ld(unsigned* p)              { return __hip_atomic_load(p, __ATOMIC_RELAXED, __HIP_MEMORY_SCOPE_AGENT); }
__device__ __forceinline__ unsigned xb_add(unsigned* p, unsigned v) { return __hip_atomic_fetch_add(p, v, __ATOMIC_RELAXED, __HIP_MEMORY_SCOPE_AGENT); }
__device__ __forceinline__ unsigned xb_xcc_id() { return (unsigned)__builtin_amdgcn_s_getreg((3 << 11) | 20) & 0xFu; }
#define XB_SPIN(cond, bar) do { unsigned _sp = 0; while (cond) { __builtin_amdgcn_s_sleep(1); \
    if ((++_sp & 255u) == 0u) { if (xb_ld(&(bar)[XB_TMO])) break; if (_sp > XB_SPIN_CAP) { atomicAdd(&(bar)[XB_TMO], 1u); break; } } } } while (0)

struct XcdBarrier {
    unsigned* bar; unsigned x;
    volatile LAS unsigned* st;
};

__device__ __forceinline__ XcdBarrier xcd_barrier_post(unsigned* bar, volatile LAS unsigned* st) {
    XcdBarrier b; b.bar = bar; b.x = xb_xcc_id(); b.st = st;
    if (threadIdx.x == 0) (void)xb_add(&bar[XB_XCNT(b.x)], 1u);
    return b;
}
__device__ __forceinline__ void xcd_barrier_complete(unsigned* bar, unsigned x, unsigned& nloc, unsigned& nx) {
    const unsigned G = gridDim.x * gridDim.y * gridDim.z;
    unsigned sum, cnt, mine, sp = 0u;
    for (;;) {
        sum = 0u; cnt = 0u; mine = 0u;
#pragma unroll
        for (unsigned j = 0; j < 16; ++j) { const unsigned c = xb_ld(&bar[XB_XCNT(j)]); sum += c; cnt += (c > 0u) ? 1u : 0u; mine = (j == x) ? c : mine; }
        if (sum == G) break;
        __builtin_amdgcn_s_sleep(1);
        if ((++sp & 255u) == 0u) { if (xb_ld(&bar[XB_TMO])) break; if (sp > XB_SPIN_CAP) { atomicAdd(&bar[XB_TMO], 1u); break; } }
    }
    nloc = mine > 0u ? mine : 1u; nx = cnt > 0u ? cnt : 1u;
}

__device__ __forceinline__ void xcd_barrier(const XcdBarrier& b) {
    asm volatile("s_waitcnt vmcnt(0)" ::: "memory");
    __syncthreads();
    if (threadIdx.x == 0) {
        unsigned* bar = b.bar;
        __builtin_amdgcn_s_waitcnt(0);
        unsigned nloc = b.st[0], nx = b.st[1];
        if (nloc == 0u) { xcd_barrier_complete(bar, b.x, nloc, nx); b.st[0] = nloc; b.st[1] = nx; }
        const unsigned old = xb_add(&bar[XB_XSUB(b.x)], 1u);
        const unsigned gen = old / nloc;
        if (old + 1u == (gen + 1u) * nloc) {
            __builtin_amdgcn_fence(__ATOMIC_RELEASE, "agent");
            asm volatile("s_waitcnt vmcnt(0)" ::: "memory");
            const unsigned og = xb_add(&bar[XB_TOP], 1u);
            const unsigned tg = og / nx;
            if (og + 1u == (tg + 1u) * nx) xb_add(&bar[XB_TOPGEN], 1u);
            else XB_SPIN(xb_ld(&bar[XB_TOPGEN]) == tg, bar);
            __builtin_amdgcn_fence(__ATOMIC_ACQUIRE, "agent");
            xb_add(&bar[XB_XGEN(b.x)], 1u);
            asm volatile("s_waitcnt vmcnt(0)" ::: "memory");
        } else {
            XB_SPIN(xb_ld(&bar[XB_XGEN(b.x)]) == gen, bar);
            __builtin_amdgcn_fence(__ATOMIC_ACQUIRE, "agent");
            asm volatile("s_waitcnt vmcnt(0)" ::: "memory");
        }
    }
    __syncthreads();
}

constexpr int NPHASE = 9;
struct Args { const float* in[13]; float* out; unsigned char* ws; int ph_lo, ph_hi, coop, pad; };
__global__ void __launch_bounds__(NWAVES * 64, 2) mega_fwd(Args args) {
    extern __shared__ __attribute__((aligned(16))) unsigned char lds[];
    cg::grid_group grid = cg::this_grid();
    Frame F;
    F.lds = (LAS unsigned char*)lds;
    F.tid = threadIdx.x; F.lane = F.tid & 63; F.wave = __builtin_amdgcn_readfirstlane(F.tid >> 6);
    F.G = gridDim.x; F.gw = blockIdx.x * NWAVES + F.wave; F.ngw = F.G * NWAVES;
    F.x = args.in[0]; F.norm_mix = args.in[1]; F.w_qkv = args.in[2]; F.w_gate = args.in[3]; F.b_gate = args.in[4]; F.rpb = args.in[5]; F.w_pa = args.in[6]; F.w_pb = args.in[7];
    F.w_out = args.in[8]; F.norm_mlp = args.in[9]; F.w_up = args.in[10]; F.w_down = args.in[11]; F.norm_final = args.in[12];
    F.out = args.out; F.ws = args.ws;
    const int lo = args.ph_lo, hi = args.ph_hi; const bool coop = args.coop != 0;
#define IN(k) (lo <= (k) && (k) < hi)
#define SEAM(k) do { if (coop && IN((k) + 1)) xcd_barrier(bar); else { asm volatile("s_waitcnt vmcnt(0) lgkmcnt(0)" ::: "memory"); __syncthreads(); } } while (0)
    volatile LAS unsigned* MISC = (volatile LAS unsigned*)(F.lds + MISC_OFF);
    for (int u = F.tid; u < 64; u += NWAVES * 64) MISC[u] = 0u;
    __syncthreads();
    XcdBarrier bar; bar.bar = (unsigned*)(args.ws + WS_CTL); bar.x = 0; bar.st = nullptr;
    if (coop) { bar = xcd_barrier_post((unsigned*)(args.ws + WS_CTL), MISC + 8); grid.sync(); }
    unsigned char* ws = args.ws;
    typedef pg8::bf16_t pb;
    if (IN(0)) { p0_prologue(F); SEAM(0); }
    if (IN(1)) {
        pg8::Gemm g{(const pb*)(ws + WS_H), (const pb*)(ws + WS_W1T), M, N1, DM}; pg8::StaticOrder S; S.init(M, N1, F.G, (int)blockIdx.x);
        pg8::EpiQkvGate E{(pb*)(ws + WS_QKV), (pb*)(ws + WS_G), F.b_gate};
        pg8::gemm_phase<pg8::EpiQkvGate, pg8::StaticOrder, true, true>(F.lds, g, S, E);
        SEAM(1);
    }
    if (IN(2)) { attn_phase(F); SEAM(2); }
    if (IN(3)) { combine_phase(F); convert_updown(F); SEAM(3); }
    if (IN(4)) {
        { pg8::Gemm g{(const pb*)(ws + WS_YB), (const pb*)(ws + WS_WPB), M, DM, WA}; pg8::StaticOrder S; S.init(M, DM, F.G, (int)blockIdx.x);
          pg8::EpiProj<true> E{(const pb*)(ws + WS_G), 2048, (pb*)(ws + WS_T), (pb*)(ws + WS_MG)};
          pg8::gemm_phase<pg8::EpiProj<true>, pg8::StaticOrder, true, true>(F.lds, g, S, E); }
        __syncthreads();
#ifndef PROBE_SKIP_PA
        { pg8::Gemm g{(const pb*)(ws + WS_YA), (const pb*)(ws + WS_WPA), M, DM, WA}; pg8::StaticOrder S; S.init(M, DM, F.G, (int)blockIdx.x);
          pg8::EpiProj<false> E{(const pb*)(ws + WS_G), 0, (pb*)(ws + WS_T), (pb*)(ws + WS_MG)};
          pg8::gemm_phase<pg8::EpiProj<false>, pg8::StaticOrder, true, true>(F.lds, g, S, E); }
#endif
        SEAM(4);
    }
    if (IN(5)) {
        pg8::Gemm g{(const pb*)(ws + WS_MG), (const pb*)(ws + WS_WOUT), M, DM, DM}; pg8::StaticOrder S; S.init(M, DM, F.G, (int)blockIdx.x);
        pg8::EpiOut E{F.x, F.out, (pb*)(ws + WS_XG2), F.norm_mlp, (float*)(ws + WS_SS1)};
        pg8::gemm_phase<pg8::EpiOut, pg8::StaticOrder, true, true>(F.lds, g, S, E);
        SEAM(5);
    }
    if (IN(6)) {
        pg8::Gemm g{(const pb*)(ws + WS_XG2), (const pb*)(ws + WS_WUPT), M, DFF, DM}; pg8::StaticOrder S; S.init(M, DFF, F.G, (int)blockIdx.x);
        pg8::EpiUp E{(pb*)(ws + WS_HM), (const float*)(ws + WS_SS1)};
        pg8::gemm_phase<pg8::EpiUp, pg8::StaticOrder, true, true>(F.lds, g, S, E);
        SEAM(6);
    }
    if (IN(7)) {
        pg8::Gemm g{(const pb*)(ws + WS_HM), (const pb*)(ws + WS_WDNT), M, DM, DFF}; pg8::StaticOrder S; S.init(M, DM, F.G, (int)blockIdx.x);
        pg8::EpiDown E{F.out, (float*)(ws + WS_SS2)};
        pg8::gemm_phase<pg8::EpiDown, pg8::StaticOrder, true, true>(F.lds, g, S, E);
        SEAM(7);
    }
    if (IN(8)) { final_phase(F); }
#undef IN
#undef SEAM
}

__global__ void dump_bf16(const unsigned short* src, float* dst, int n) { for (int i = blockIdx.x * blockDim.x + threadIdx.x; i < n; i += gridDim.x * blockDim.x) dst[i] = __uint_as_float((unsigned)src[i] << 16); }
#ifndef MK_N_LAUNCHES
#define MK_N_LAUNCHES 9
#endif
extern "C" void kernel_launch(void* const* d_in, const int* in_sizes, int n_in, void* d_out, int out_size, void* d_ws, size_t ws_size, hipStream_t stream) {
    static int grid = 0;
    if (grid == 0) {
        if (n_in != 13 || out_size != M * DM || ws_size < WS_END) { fprintf(stderr, "kernel_launch: unexpected shapes (n_in %d out %d ws %zu need %zu)\n", n_in, out_size, ws_size, (size_t)WS_END); grid = -1; return; }
        int dev = 0, cus = 0, per_cu = 0;
        hipGetDevice(&dev); hipDeviceGetAttribute(&cus, hipDeviceAttributeMultiprocessorCount, dev);
        hipFuncSetAttribute((const void*)mega_fwd, hipFuncAttributeMaxDynamicSharedMemorySize, LDS_BYTES);
        hipOccupancyMaxActiveBlocksPerMultiprocessor(&per_cu, (const void*)mega_fwd, NWAVES * 64, LDS_BYTES);
        (void)hipGetLastError();
        if (per_cu < 1) per_cu = 1;
        grid = cus;
    }
    if (grid < 0) return;
    Args a{};
    for (int i = 0; i < 13; ++i) a.in[i] = (const float*)d_in[i];
    a.out = (float*)d_out; a.ws = (unsigned char*)d_ws;
#if MK_N_LAUNCHES == 1
    if (hipMemsetAsync((char*)d_ws + WS_CTL, 0, CTL_ZERO_BYTES, stream) != hipSuccess) { fprintf(stderr, "memset failed\n"); return; }
    a.ph_lo = 0; a.ph_hi = NPHASE; a.coop = 1;
    void* kargs[] = {&a};
    hipError_t e = hipLaunchCooperativeKernel((const void*)mega_fwd, dim3(grid), dim3(NWAVES * 64), kargs, LDS_BYTES, stream);
    if (e != hipSuccess) fprintf(stderr, "cooperative launch failed: %s (grid %d)\n", hipGetErrorString(e), grid);
#else
#ifndef PROBE_STOP
#define PROBE_STOP NPHASE
#endif
    for (int p = 0; p < PROBE_STOP; ++p) {
        a.ph_lo = p; a.ph_hi = p + 1; a.coop = 0;
        hipLaunchKernelGGL(mega_fwd, dim3(grid), dim3(NWAVES * 64), LDS_BYTES, stream, a);
    }
#ifdef PROBE_DUMP_OFF
    hipLaunchKernelGGL(dump_bf16, dim3(2048), dim3(256), 0, stream, (const unsigned short*)((char*)d_ws + PROBE_DUMP_OFF), (float*)d_out, M * DM);
#endif
#endif
}
```

```cpp
#include <hip/hip_runtime.h>
#include <hip/hip_cooperative_groups.h>
#include <cstdio>
#include <cstdint>
namespace cg = cooperative_groups;
namespace pg8 {
#define PG8_LAS __attribute__((address_space(3)))
typedef unsigned short bf16_t;
typedef short bf16x8 __attribute__((ext_vector_type(8)));
typedef float f32x4 __attribute__((ext_vector_type(4)));
typedef unsigned u32x4 __attribute__((ext_vector_type(4)));
constexpr int BM = 256, BK = 64, HALF = 128, HTB = HALF * BK * 2  , STAGE_BYTES = 8 * HTB, NXCD = 8, WGM = 8;

__host__ __device__ __forceinline__ int lds_byte(int r, int c) { const int st = (r >> 4) * 2 + (c >> 5), rr = r & 15, cc = c & 31, ob = rr * 64 + cc * 2; return st * 1024 + (ob ^ (((ob >> 9) & 1) << 5)); }
__host__ __device__ __forceinline__ void stage_rc(int b, int& R, int& C) { const int st = b / 1024, sb = b % 1024, swz = sb ^ (((sb >> 9) & 1) << 5); R = (st >> 1) * 16 + swz / 64; C = (st & 1) * 32 + (swz % 64) / 2; }
__host__ __device__ __forceinline__ int perm32(int rho) { const int n = rho >> 4, i = rho & 15; return 8 * (i >> 2) + 4 * n + (i & 3); }

struct Unit { int pm, pn; };
struct Gemm { const bf16_t* A; const bf16_t* Bt; int M, N, K; };

struct StaticOrder {
    int nM, nN, nwg, G, c;
    __host__ __device__ void init(int M, int N, int G_, int c_) { nM = M / BM; nN = N / BM; nwg = nM * nN; G = G_; c = c_; }
    __host__ __device__ bool next(int i, Unit& u) const {
        const long L = (long)i * G + c; if (L >= nwg) return false;
        int wgid = (int)L; { const int q = nwg / NXCD, r = nwg % NXCD, xcd = wgid % NXCD, off = wgid / NXCD; wgid = (xcd < r ? xcd * (q + 1) : r * (q + 1) + (xcd - r) * q) + off; }
        const int nig = WGM * nN, gid = wgid / nig, fm = gid * WGM, gsz = (nM - fm) < WGM ? (nM - fm) : WGM;
        u.pm = fm + ((wgid % nig) % gsz); u.pn = (wgid % nig) / gsz; return true;
    }
    __device__ __forceinline__ void a_ready(const Unit&) const {}
    __device__ __forceinline__ void done(const Unit&) const {}
};
typedef __bf16 pg8_bf16x2 __attribute__((ext_vector_type(2)));
typedef float pg8_f32x2 __attribute__((ext_vector_type(2)));
__device__ __forceinline__ unsigned cvt_pk_bf16(float lo, float hi) { pg8_f32x2 v = {lo, hi}; pg8_bf16x2 b = __builtin_convertvector(v, pg8_bf16x2); return __builtin_bit_cast(unsigned, b); }
__device__ __forceinline__ u32x4 pack8(const f32x4 v0, const f32x4 v1) { u32x4 w; w.x = cvt_pk_bf16(v0[0], v0[1]); w.y = cvt_pk_bf16(v0[2], v0[3]); w.z = cvt_pk_bf16(v1[0], v1[1]); w.w = cvt_pk_bf16(v1[2], v1[3]); return w; }
__device__ __forceinline__ void unpack8(const u32x4 w, f32x4& v0, f32x4& v1) {
    v0[0] = __uint_as_float(w.x << 16); v0[1] = __uint_as_float(w.x & 0xffff0000u); v0[2] = __uint_as_float(w.y << 16); v0[3] = __uint_as_float(w.y & 0xffff0000u);
    v1[0] = __uint_as_float(w.z << 16); v1[1] = __uint_as_float(w.z & 0xffff0000u); v1[2] = __uint_as_float(w.w << 16); v1[3] = __uint_as_float(w.w & 0xffff0000u); }
__device__ __forceinline__ float sigmoidf_fast(float x) { return __builtin_amdgcn_rcpf(1.0f + __expf(-x)); }

struct EpiQkvGate {
    static constexpr bool PERM = true, AFTER_DRAIN = false;
    bf16_t* QKV; bf16_t* G; const float* bgate;
    __device__ __forceinline__ void operator()(const f32x4 (&acc)[2][2][4][2], const Unit& u, int wr, int wc, int fr, int fq) const {
        const int row0 = u.pm * BM + wr * 64 + fr, colt = u.pn * BM, cw = wc * 32 + 8 * fq;
        if (colt < 6144) {
#pragma unroll
            for (int ai = 0; ai < 2; ++ai)
#pragma unroll
                for (int m = 0; m < 4; ++m) { bf16_t* rowp = QKV + (size_t)(row0 + ai * HALF + m * 16) * 6144 + colt + cw;
#pragma unroll
                    for (int bj = 0; bj < 2; ++bj) *(u32x4*)(rowp + bj * HALF) = pack8(acc[ai][bj][m][0], acc[ai][bj][m][1]); }
        } else {
            const int gc = colt - 6144 + cw;
            f32x4 bv[2][2];
#pragma unroll
            for (int bj = 0; bj < 2; ++bj)
#pragma unroll
                for (int n = 0; n < 2; ++n) bv[bj][n] = *(const f32x4*)(bgate + gc + bj * HALF + 4 * n);
#pragma unroll
            for (int ai = 0; ai < 2; ++ai)
#pragma unroll
                for (int m = 0; m < 4; ++m) { bf16_t* rowp = G + (size_t)(row0 + ai * HALF + m * 16) * 4096 + gc;
#pragma unroll
                    for (int bj = 0; bj < 2; ++bj) { f32x4 v0 = acc[ai][bj][m][0] + bv[bj][0], v1 = acc[ai][bj][m][1] + bv[bj][1];
#pragma unroll
                        for (int e = 0; e < 4; ++e) { v0[e] = sigmoidf_fast(v0[e]); v1[e] = sigmoidf_fast(v1[e]); }
                        *(u32x4*)(rowp + bj * HALF) = pack8(v0, v1); } }
        }
    }
};
template <bool FIRST> struct EpiProj {
    static constexpr bool PERM = true, AFTER_DRAIN = false;
    const bf16_t* G; int goff; bf16_t* T; bf16_t* O;
    __device__ __forceinline__ void operator()(const f32x4 (&acc)[2][2][4][2], const Unit& u, int wr, int wc, int fr, int fq) const {
        const int row0 = u.pm * BM + wr * 64 + fr, col0 = u.pn * BM + wc * 32 + 8 * fq;
#pragma unroll
        for (int ai = 0; ai < 2; ++ai)
#pragma unroll
            for (int m = 0; m < 4; ++m) { const size_t row = (size_t)(row0 + ai * HALF + m * 16);
#pragma unroll
                for (int bj = 0; bj < 2; ++bj) { const int col = col0 + bj * HALF;
                    f32x4 g0, g1; unpack8(*(const u32x4*)(G + row * 4096 + goff + col), g0, g1);
                    f32x4 v0 = acc[ai][bj][m][0] * g0, v1 = acc[ai][bj][m][1] * g1;
                    if (!FIRST) { f32x4 t0, t1; unpack8(*(const u32x4*)(T + row * 2048 + col), t0, t1); v0 += t0; v1 += t1; }
                    *(u32x4*)((FIRST ? T : O) + row * 2048 + col) = pack8(v0, v1); } }
    }
};
struct EpiOut {
    static constexpr bool PERM = true, AFTER_DRAIN = false;
    const float* X; float* X1; bf16_t* XG; const float* gmlp; float* SS;
    __device__ __forceinline__ void operator()(const f32x4 (&acc)[2][2][4][2], const Unit& u, int wr, int wc, int fr, int fq) const {
        const int row0 = u.pm * BM + wr * 64 + fr, col0 = u.pn * BM + wc * 32 + 8 * fq;
        f32x4 gv[2][2];
#pragma unroll
        for (int bj = 0; bj < 2; ++bj)
#pragma unroll
            for (int n = 0; n < 2; ++n) gv[bj][n] = *(const f32x4*)(gmlp + col0 + bj * HALF + 4 * n);
#pragma unroll
        for (int ai = 0; ai < 2; ++ai)
#pragma unroll
            for (int m = 0; m < 4; ++m) { const size_t row = (size_t)(row0 + ai * HALF + m * 16); float ss = 0.f;
#pragma unroll
                for (int bj = 0; bj < 2; ++bj) { const size_t off = row * 2048 + col0 + bj * HALF;
                    const f32x4 x0 = *(const f32x4*)(X + off), x1 = *(const f32x4*)(X + off + 4);
                    const f32x4 v0 = acc[ai][bj][m][0] + x0, v1 = acc[ai][bj][m][1] + x1;
                    *(f32x4*)(X1 + off) = v0; *(f32x4*)(X1 + off + 4) = v1;
                    ss += (v0[0] * v0[0] + v0[1] * v0[1]) + (v0[2] * v0[2] + v0[3] * v0[3]) + (v1[0] * v1[0] + v1[1] * v1[1]) + (v1[2] * v1[2] + v1[3] * v1[3]);
                    *(u32x4*)(XG + off) = pack8(v0 * gv[bj][0], v1 * gv[bj][1]); }
                ss += __shfl_xor(ss, 16); ss += __shfl_xor(ss, 32);
                if (fq == 0) __hip_atomic_fetch_add(SS + row, ss, __ATOMIC_RELAXED, __HIP_MEMORY_SCOPE_AGENT); }
    }
};
struct EpiUp {
    static constexpr bool PERM = true, AFTER_DRAIN = false;
    bf16_t* H; const float* SS;
    __device__ __forceinline__ void operator()(const f32x4 (&acc)[2][2][4][2], const Unit& u, int wr, int wc, int fr, int fq) const {
        const int row0 = u.pm * BM + wr * 64 + fr, col0 = u.pn * BM + wc * 32 + 8 * fq;
#pragma unroll
        for (int ai = 0; ai < 2; ++ai)
#pragma unroll
            for (int m = 0; m < 4; ++m) { const size_t row = (size_t)(row0 + ai * HALF + m * 16);
                const float rs = __builtin_amdgcn_rsqf(__hip_atomic_load(SS + row, __ATOMIC_RELAXED, __HIP_MEMORY_SCOPE_AGENT) * (1.0f / 2048.0f) + 1e-6f);
#pragma unroll
                for (int bj = 0; bj < 2; ++bj) { f32x4 v0 = acc[ai][bj][m][0] * rs, v1 = acc[ai][bj][m][1] * rs;
#pragma unroll
                    for (int e = 0; e < 4; ++e) { const float a = fmaxf(v0[e], 0.f), b = fmaxf(v1[e], 0.f); v0[e] = a * a; v1[e] = b * b; }
                    *(u32x4*)(H + row * 8192 + col0 + bj * HALF) = pack8(v0, v1); } }
    }
};
struct EpiDown {
    static constexpr bool PERM = true, AFTER_DRAIN = false;
    float* X1; float* SS;
    __device__ __forceinline__ void operator()(const f32x4 (&acc)[2][2][4][2], const Unit& u, int wr, int wc, int fr, int fq) const {
        const int row0 = u.pm * BM + wr * 64 + fr, col0 = u.pn * BM + wc * 32 + 8 * fq;
#pragma unroll
        for (int ai = 0; ai < 2; ++ai)
#pragma unroll
            for (int m = 0; m < 4; ++m) { const size_t row = (size_t)(row0 + ai * HALF + m * 16); float ss = 0.f;
#pragma unroll
                for (int bj = 0; bj < 2; ++bj) { const size_t off = row * 2048 + col0 + bj * HALF;
                    const f32x4 x0 = *(const f32x4*)(X1 + off), x1 = *(const f32x4*)(X1 + off + 4);
                    const f32x4 v0 = acc[ai][bj][m][0] + x0, v1 = acc[ai][bj][m][1] + x1;
                    *(f32x4*)(X1 + off) = v0; *(f32x4*)(X1 + off + 4) = v1;
                    ss += (v0[0] * v0[0] + v0[1] * v0[1]) + (v0[2] * v0[2] + v0[3] * v0[3]) + (v1[0] * v1[0] + v1[1] * v1[1]) + (v1[2] * v1[2] + v1[3] * v1[3]); }
                ss += __shfl_xor(ss, 16); ss += __shfl_xor(ss, 32);
                if (fq == 0) __hip_atomic_fetch_add(SS + row, ss, __ATOMIC_RELAXED, __HIP_MEMORY_SCOPE_AGENT); }
    }
};
template <class Epi, class Sched, bool ALIGN_EPI = false, bool SP2 = false>
__device__ __forceinline__ void gemm_phase(PG8_LAS unsigned char* lds, const Gemm g, const Sched& S, const Epi& E) {
    const int tid = threadIdx.x, wid = __builtin_amdgcn_readfirstlane(tid >> 6), lane = tid & 63, wr = wid >> 2, wc = wid & 3, fr = lane & 15, fq = lane >> 4;
    const int K = g.K, nt = K / BK;
    unsigned voffA[2], voffB[2];
#pragma unroll
    for (int i = 0; i < 2; ++i) { int R, C; stage_rc(tid * 16 + i * 8192, R, C); const int Rb = Epi::PERM ? ((R & ~31) + perm32(R & 31)) : R;
        voffA[i] = (unsigned)(R * K + C) * 2u; voffB[i] = (unsigned)(Rb * K + C) * 2u; }
    const size_t kstep = (size_t)(BK * 2);
    const size_t hstep = (size_t)HALF * K * 2;
    const size_t tstep = 2 * hstep;
    const unsigned ldsw = (unsigned)wid * 1024u;
    const int aoff = lds_byte(wr * 64 + fr, fq * 8), boff = lds_byte(wc * 32 + fr, fq * 8);
#define PG8_SA(b, h) (((b) * 2 + (h)) * HTB)
#define PG8_SB(b, h) ((4 + (b) * 2 + (h)) * HTB)
#define PG8_STAGE(bufoff, gbase, voff) do { _Pragma("unroll") for (int _i = 0; _i < 2; ++_i) \
        __builtin_amdgcn_global_load_lds((const unsigned*)((const char*)(gbase) + (voff)[_i]), (PG8_LAS unsigned*)(lds + (bufoff) + ldsw + _i * 8192), 16, 0, 0); } while (0)
#define PG8_LDA(dst, b, h) do { _Pragma("unroll") for (int m = 0; m < 4; ++m) _Pragma("unroll") for (int k = 0; k < 2; ++k) dst[m][k] = *(const PG8_LAS bf16x8*)(lds + PG8_SA(b, h) + aoff + m * 2048 + k * 1024); } while (0)
#define PG8_LDB(dst, b, h) do { _Pragma("unroll") for (int n = 0; n < 2; ++n) _Pragma("unroll") for (int k = 0; k < 2; ++k) dst[n][k] = *(const PG8_LAS bf16x8*)(lds + PG8_SB(b, h) + boff + n * 2048 + k * 1024); } while (0)
#define PG8_MMA(ai, bj, At, Bt) do { __builtin_amdgcn_s_setprio(1); _Pragma("unroll") for (int m = 0; m < 4; ++m) _Pragma("unroll") for (int n = 0; n < 2; ++n) _Pragma("unroll") for (int k = 0; k < 2; ++k) \
        acc[ai][bj][m][n] = __builtin_amdgcn_mfma_f32_16x16x32_bf16(Bt[n][k], At[m][k], acc[ai][bj][m][n], 0, 0, 0); __builtin_amdgcn_s_setprio(0); } while (0)
#define PG8_WAIT_V(n) asm volatile("s_waitcnt vmcnt(" #n ")" ::: "memory")
#define PG8_WAIT_L(n) asm volatile("s_waitcnt lgkmcnt(" #n ")" ::: "memory")
#define PG8_BAR __builtin_amdgcn_s_barrier()
#define PG8_SCHED __builtin_amdgcn_sched_barrier(0)
    Unit cur, nxt; int ui = 0;
    if (!S.next(0, cur)) return;
    f32x4 acc[2][2][4][2];
#pragma unroll
    for (int a = 0; a < 2; ++a)
#pragma unroll
        for (int b = 0; b < 2; ++b)
#pragma unroll
            for (int m = 0; m < 4; ++m)
#pragma unroll
                for (int n = 0; n < 2; ++n) acc[a][b][m][n] = (f32x4){0.f, 0.f, 0.f, 0.f};
    bf16x8 At[4][2], B0[2][2], B1[2][2];
    const char* cA = (const char*)g.A + (size_t)cur.pm * tstep; const char* cB = (const char*)g.Bt + (size_t)cur.pn * tstep;
    S.a_ready(cur);
    if constexpr (SP2) {
        PG8_STAGE(PG8_SB(0, 0), cB, voffB); PG8_STAGE(PG8_SB(0, 1), cB + hstep, voffB); PG8_STAGE(PG8_SA(0, 0), cA, voffA); PG8_STAGE(PG8_SA(0, 1), cA + hstep, voffA);
        if (wr == 1) PG8_BAR;
        PG8_WAIT_V(2); PG8_BAR;
        PG8_STAGE(PG8_SB(1, 0), cB + kstep, voffB); PG8_STAGE(PG8_SA(1, 0), cA + kstep, voffA); PG8_STAGE(PG8_SB(1, 1), cB + hstep + kstep, voffB);
        PG8_WAIT_V(6); PG8_BAR;
    } else {
        PG8_STAGE(PG8_SB(0, 0), cB, voffB); PG8_STAGE(PG8_SA(0, 0), cA, voffA); PG8_STAGE(PG8_SB(0, 1), cB + hstep, voffB); PG8_STAGE(PG8_SA(0, 1), cA + hstep, voffA);
        if (wr == 1) PG8_BAR;
        PG8_WAIT_V(4); PG8_BAR;
        PG8_STAGE(PG8_SB(1, 0), cB + kstep, voffB); PG8_STAGE(PG8_SA(1, 0), cA + kstep, voffA); PG8_STAGE(PG8_SB(1, 1), cB + hstep + kstep, voffB);
        PG8_WAIT_V(6); PG8_BAR;
    }
    for (;;) {
        const bool has_next = S.next(ui + 1, nxt);
        const char* nA = has_next ? (const char*)g.A + (size_t)nxt.pm * tstep : cA; const char* nB = has_next ? (const char*)g.Bt + (size_t)nxt.pn * tstep : cB;
        for (int t = 0; t < nt; t += 2) {
            const bool last = (t == nt - 2);
            const char* a1 = cA + (size_t)(t + 1) * kstep;
            const char* a2 = last ? nA : cA + (size_t)(t + 2) * kstep; const char* b2 = last ? nB : cB + (size_t)(t + 2) * kstep;
            const char* a3 = a2 + kstep; const char* b3 = b2 + kstep;
            if (last && has_next) S.a_ready(nxt);
            if constexpr (SP2) {
            PG8_LDB(B0, 0, 0); PG8_LDB(B1, 0, 1); PG8_SCHED; PG8_LDA(At, 0, 0); PG8_STAGE(PG8_SA(1, 1), a1 + hstep, voffA);
            PG8_WAIT_V(8); PG8_WAIT_L(0); PG8_BAR; PG8_MMA(0, 0, At, B0); PG8_MMA(0, 1, At, B1); PG8_BAR; PG8_SCHED;
            PG8_LDA(At, 0, 1); PG8_STAGE(PG8_SB(0, 0), b2, voffB); PG8_STAGE(PG8_SB(0, 1), b2 + hstep, voffB); PG8_STAGE(PG8_SA(0, 0), a2, voffA);
            PG8_WAIT_V(8); PG8_WAIT_L(0); PG8_BAR; PG8_MMA(1, 0, At, B0); PG8_MMA(1, 1, At, B1); PG8_BAR; PG8_SCHED;
            PG8_LDB(B0, 1, 0); PG8_LDB(B1, 1, 1); PG8_SCHED; PG8_LDA(At, 1, 0); PG8_STAGE(PG8_SA(0, 1), a2 + hstep, voffA);
            PG8_WAIT_V(8); PG8_WAIT_L(0); PG8_BAR; PG8_MMA(0, 0, At, B0); PG8_MMA(0, 1, At, B1); PG8_BAR; PG8_SCHED;
            PG8_LDA(At, 1, 1); PG8_STAGE(PG8_SB(1, 0), b3, voffB); PG8_STAGE(PG8_SB(1, 1), b3 + hstep, voffB); PG8_STAGE(PG8_SA(1, 0), a3, voffA);
            PG8_WAIT_V(8); PG8_WAIT_L(0); PG8_BAR; PG8_MMA(1, 0, At, B0); PG8_MMA(1, 1, At, B1); PG8_BAR; PG8_SCHED;
            } else {
            PG8_LDB(B0, 0, 0); PG8_SCHED; PG8_LDA(At, 0, 0); PG8_STAGE(PG8_SA(1, 1), a1 + hstep, voffA);
            PG8_WAIT_L(8); PG8_BAR; PG8_WAIT_L(0); PG8_MMA(0, 0, At, B0); PG8_BAR; PG8_SCHED;
            PG8_LDB(B1, 0, 1); PG8_STAGE(PG8_SB(0, 0), b2, voffB);
            PG8_BAR; PG8_WAIT_L(0); PG8_MMA(0, 1, At, B1); PG8_BAR;
            PG8_LDA(At, 0, 1); PG8_STAGE(PG8_SA(0, 0), a2, voffA);
            PG8_BAR; PG8_WAIT_L(0); PG8_MMA(1, 0, At, B0); PG8_BAR; PG8_SCHED;
            PG8_STAGE(PG8_SB(0, 1), b2 + hstep, voffB);
            PG8_WAIT_V(6); PG8_BAR; PG8_MMA(1, 1, At, B1); PG8_BAR;
            PG8_LDB(B0, 1, 0); PG8_SCHED; PG8_LDA(At, 1, 0); PG8_STAGE(PG8_SA(0, 1), a2 + hstep, voffA);
            PG8_WAIT_L(8); PG8_BAR; PG8_WAIT_L(0); PG8_MMA(0, 0, At, B0); PG8_BAR; PG8_SCHED;
            PG8_LDB(B1, 1, 1); PG8_STAGE(PG8_SB(1, 0), b3, voffB);
            PG8_BAR; PG8_WAIT_L(0); PG8_MMA(0, 1, At, B1); PG8_BAR;
            PG8_LDA(At, 1, 1); PG8_STAGE(PG8_SA(1, 0), a3, voffA);
            PG8_BAR; PG8_WAIT_L(0); PG8_MMA(1, 0, At, B0); PG8_BAR; PG8_SCHED;
            PG8_STAGE(PG8_SB(1, 1), b3 + hstep, voffB);
            PG8_WAIT_V(6); PG8_BAR; PG8_MMA(1, 1, At, B1); PG8_BAR;
            }
        }
        if constexpr (ALIGN_EPI) { if (wr == 0) PG8_BAR; }
        if constexpr (!Epi::AFTER_DRAIN) { E(acc, cur, wr, wc, fr, fq); S.done(cur); }
        if (!has_next) break;
#pragma unroll
        for (int a = 0; a < 2; ++a)
#pragma unroll
            for (int b = 0; b < 2; ++b)
#pragma unroll
                for (int m = 0; m < 4; ++m)
#pragma unroll
                    for (int n = 0; n < 2; ++n) acc[a][b][m][n] = (f32x4){0.f, 0.f, 0.f, 0.f};
        cur = nxt; cA = nA; cB = nB; ++ui;
        if constexpr (ALIGN_EPI) { if (wr == 1) PG8_BAR; }
    }
    PG8_WAIT_V(0);
    if constexpr (!ALIGN_EPI) { if (wr == 0) PG8_BAR; }
    PG8_BAR;
    if constexpr (Epi::AFTER_DRAIN) { E.fused(acc, cur, wr, wc, fr, fq, lds, wid, lane); S.done(cur); }
#undef PG8_SA
#undef PG8_SB
#undef PG8_STAGE
#undef PG8_LDA
#undef PG8_LDB
#undef PG8_MMA
#undef PG8_WAIT_V
#undef PG8_WAIT_L
#undef PG8_BAR
#undef PG8_SCHED
}
}

constexpr int NWAVES = 8;
constexpr int SEQ = 4096, DM = 2048, M = 2 * SEQ, NQKV = 6144, NG = 4096, N1 = NQKV + NG, DFF = 8192, WA = 512;
constexpr float EPS = 1e-6f, LOG2E = 1.4426950408889634f;
constexpr size_t MiB = 1u << 20;
constexpr size_t WS_SS1 = 0, WS_SS2 = 32768, WS_LSE = 65536;
constexpr size_t WS_WPA = 1 * MiB, WS_WPB = 3 * MiB, WS_WOUT = 5 * MiB;
constexpr size_t WS_YA = 13 * MiB, WS_YB = 21 * MiB;
constexpr size_t WS_RA = 29 * MiB;
constexpr size_t WS_H = WS_RA, WS_W1T = WS_RA + 32 * MiB, WS_WUPT = WS_RA, WS_WDNT = WS_RA + 32 * MiB;
constexpr size_t WS_RB = 101 * MiB;
constexpr size_t WS_QKV = WS_RB, WS_G = WS_RB + 96 * MiB;
constexpr size_t WS_T = WS_RB, WS_MG = WS_RB + 32 * MiB;
constexpr size_t WS_HM = WS_RB;
constexpr size_t WS_XG2 = WS_RB + 128 * MiB;
constexpr size_t WS_END = WS_RB + 160 * MiB;

constexpr size_t WS_CTL = 512 * 1024, CTL_ZERO_BYTES = 16384;
constexpr int MISC_OFF = 131072;
constexpr int LDS_BYTES = 131072 + 1024;

#define LAS __attribute__((address_space(3)))
typedef unsigned short bf16;
typedef unsigned v4u __attribute__((ext_vector_type(4)));
typedef unsigned v2u __attribute__((ext_vector_type(2)));
typedef float f32x4 __attribute__((ext_vector_type(4)));
typedef float f32x16 __attribute__((ext_vector_type(16)));
typedef short bf16x8 __attribute__((ext_vector_type(8)));
#define LDS_WAIT() asm volatile("s_waitcnt lgkmcnt(0)" ::: "memory")
__device__ __forceinline__ unsigned f2bf(float f) { unsigned u = __builtin_bit_cast(unsigned, f); return (u + 0x7fffu + ((u >> 16) & 1u)) >> 16; }
__device__ __forceinline__ unsigned pk2(float lo, float hi) { return f2bf(lo) | (f2bf(hi) << 16); }
__device__ __forceinline__ float bflo(unsigned w) { return __uint_as_float(w << 16); }
__device__ __forceinline__ float bfhi(unsigned w) { return __uint_as_float(w & 0xffff0000u); }
__device__ __forceinline__ float wave_sum(float v) {
#pragma unroll
    for (int o = 1; o < 64; o <<= 1) v += __shfl_xor(v, o);
    return v;
}

struct Frame {
    LAS unsigned char* lds;
    int tid, lane, wave, G, gw, ngw;
    const float *x, *norm_mix, *w_qkv, *w_gate, *b_gate, *rpb, *w_pa, *w_pb, *w_out, *norm_mlp, *w_up, *w_down, *norm_final;
    float* out; unsigned char* ws;
};

__device__ __forceinline__ void transpose_item(const float* W, int K, int N, bf16* WT, int row_off, LAS float* scr, int item, int lane) {
    const int nblk = N / 32, kb = item / nblk, nb = item % nblk, k0 = 64 * kb, n0 = 32 * nb;
#pragma unroll 8
    for (int i = 0; i < 32; ++i) { const int kk = 2 * i + (lane >> 5); scr[kk * 33 + (lane & 31)] = W[(size_t)(k0 + kk) * N + n0 + (lane & 31)]; }
    LDS_WAIT(); asm volatile("" ::: "memory");
    const int c = lane & 7;
#pragma unroll
    for (int j = 0; j < 4; ++j) { const int n = (lane >> 3) + 8 * j; const LAS float* s = scr + (8 * c) * 33 + n;
        v4u o; o.x = pk2(s[0 * 33], s[1 * 33]); o.y = pk2(s[2 * 33], s[3 * 33]); o.z = pk2(s[4 * 33], s[5 * 33]); o.w = pk2(s[6 * 33], s[7 * 33]);
        *(v4u*)(WT + (size_t)(row_off + n0 + n) * K + k0 + 8 * c) = o; }
    LDS_WAIT(); asm volatile("" ::: "memory");
}

__device__ __forceinline__ void p0_prologue(Frame& F) {
    LAS float* scr = (LAS float*)(F.lds + F.wave * 16384);
    bf16* W1t = (bf16*)(F.ws + WS_W1T);
    constexpr int I_QKV = (DM / 64) * (NQKV / 32), I_G = (DM / 64) * (NG / 32), I_P = (WA / 64) * (DM / 32), I_O = (DM / 64) * (DM / 32);
    constexpr int NITEMS = I_QKV + I_G + 2 * I_P + I_O;
    for (int it = F.gw; it < NITEMS; it += F.ngw) {
        int r = it;
        if (r < I_QKV) { transpose_item(F.w_qkv, DM, NQKV, W1t, 0, scr, r, F.lane); continue; } r -= I_QKV;
        if (r < I_G) { transpose_item(F.w_gate, DM, NG, W1t, NQKV, scr, r, F.lane); continue; } r -= I_G;
        if (r < I_P) { transpose_item(F.w_pa, WA, DM, (bf16*)(F.ws + WS_WPA), 0, scr, r, F.lane); continue; } r -= I_P;
        if (r < I_P) { transpose_item(F.w_pb, WA, DM, (bf16*)(F.ws + WS_WPB), 0, scr, r, F.lane); continue; } r -= I_P;
        transpose_item(F.w_out, DM, DM, (bf16*)(F.ws + WS_WOUT), 0, scr, r, F.lane);
    }
    bf16* H = (bf16*)(F.ws + WS_H);
    for (int m = F.gw; m < M; m += F.ngw) {
        const f32x4* xr = (const f32x4*)(F.x + (size_t)m * DM) + F.lane;
        f32x4 v[8]; float s = 0.f;
#pragma unroll
        for (int j = 0; j < 8; ++j) { v[j] = xr[64 * j]; s += (v[j].x * v[j].x + v[j].y * v[j].y) + (v[j].z * v[j].z + v[j].w * v[j].w); }
        const float rstd = 1.0f / sqrtf(wave_sum(s) * (1.0f / DM) + EPS);
        v2u* o8 = (v2u*)(H + (size_t)m * DM) + F.lane;
#pragma unroll
        for (int j = 0; j < 8; ++j) { const f32x4 g = ((const f32x4*)F.norm_mix)[F.lane + 64 * j]; v2u o; o.x = pk2(v[j].x * rstd * g.x, v[j].y * rstd * g.y); o.y = pk2(v[j].z * rstd * g.z, v[j].w * rstd * g.w); o8[64 * j] = o; }
    }
    float* ss = (float*)(F.ws + WS_SS1);
    for (int i = blockIdx.x * 512 + F.tid; i < 16384; i += F.G * 512) ss[i] = 0.f;
}

__device__ __forceinline__ void convert_updown(Frame& F) {
    LAS float* scr = (LAS float*)(F.lds + F.wave * 16384);
    constexpr int I_U = (DM / 64) * (DFF / 32), I_D = (DFF / 64) * (DM / 32);
    for (int it = F.gw; it < I_U + I_D; it += F.ngw) {
        if (it < I_U) transpose_item(F.w_up, DM, DFF, (bf16*)(F.ws + WS_WUPT), 0, scr, it, F.lane);
        else transpose_item(F.w_down, DFF, DM, (bf16*)(F.ws + WS_WDNT), 0, scr, it - I_U, F.lane);
    }
}

#define MFMA32(a, b, c) __builtin_amdgcn_mfma_f32_32x32x16_bf16((a), (b), (c), 0, 0, 0)
constexpr int VT_PITCH = 80;
constexpr float NEGF = -1e30f;
typedef __bf16 bf16x2_t __attribute__((ext_vector_type(2)));
typedef float f32x2_t __attribute__((ext_vector_type(2)));
__device__ __forceinline__ unsigned cvtpk(float lo, float hi) { f32x2_t v = {lo, hi}; bf16x2_t b = __builtin_convertvector(v, bf16x2_t); return __builtin_bit_cast(unsigned, b); }

struct AttnAcc { f32x16 o[4]; float m, l; };

__device__ __forceinline__ void attn_tile_update(AttnAcc& A, const f32x16& s2, const bf16* QKV, size_t vrow, int vcol, LAS unsigned char* vt, int lane) {
    const int key = lane & 31, dh = lane >> 5, hi = lane >> 5;
    v4u vv[8];
#pragma unroll
    for (int c = 0; c < 8; ++c) vv[c] = *(const v4u*)(QKV + vrow * NQKV + vcol + 8 * c);
    float tmax = s2[0];
#pragma unroll
    for (int r = 1; r < 16; ++r) tmax = fmaxf(tmax, s2[r]);
    tmax = fmaxf(tmax, __shfl_xor(tmax, 32));
    const float mnew = fmaxf(A.m, tmax);
    const float alpha = __builtin_amdgcn_exp2f(A.m - mnew);
    A.m = mnew;
    float p[16]; float ps = 0.f;
#pragma unroll
    for (int r = 0; r < 16; ++r) { p[r] = (s2[r] > -1e29f) ? __builtin_amdgcn_exp2f(s2[r] - mnew) : 0.f; ps += p[r]; }
    A.l = A.l * alpha + ps;
#pragma unroll
    for (int dt = 0; dt < 4; ++dt) A.o[dt] = A.o[dt] * alpha;
    bf16x8 pf[2];
#pragma unroll
    for (int s = 0; s < 2; ++s) { v4u w; w.x = cvtpk(p[8 * s + 0], p[8 * s + 1]); w.y = cvtpk(p[8 * s + 2], p[8 * s + 3]); w.z = cvtpk(p[8 * s + 4], p[8 * s + 5]); w.w = cvtpk(p[8 * s + 6], p[8 * s + 7]); pf[s] = __builtin_bit_cast(bf16x8, w); }
    LAS unsigned short* vw = (LAS unsigned short*)(vt + (64 * dh) * VT_PITCH + key * 2);
#pragma unroll
    for (int c = 0; c < 8; ++c) {
        const unsigned w0 = vv[c].x, w1 = vv[c].y, w2 = vv[c].z, w3 = vv[c].w;
        vw[((8 * c + 0) * VT_PITCH) / 2] = (unsigned short)(w0 & 0xffffu); vw[((8 * c + 1) * VT_PITCH) / 2] = (unsigned short)(w0 >> 16);
        vw[((8 * c + 2) * VT_PITCH) / 2] = (unsigned short)(w1 & 0xffffu); vw[((8 * c + 3) * VT_PITCH) / 2] = (unsigned short)(w1 >> 16);
        vw[((8 * c + 4) * VT_PITCH) / 2] = (unsigned short)(w2 & 0xffffu); vw[((8 * c + 5) * VT_PITCH) / 2] = (unsigned short)(w2 >> 16);
        vw[((8 * c + 6) * VT_PITCH) / 2] = (unsigned short)(w3 & 0xffffu); vw[((8 * c + 7) * VT_PITCH) / 2] = (unsigned short)(w3 >> 16);
    }
    LDS_WAIT();
    const LAS unsigned char* vr = vt + (lane & 31) * VT_PITCH + 16 * hi;
#pragma unroll
    for (int dt = 0; dt < 4; ++dt)
#pragma unroll
        for (int s = 0; s < 2; ++s) { const bf16x8 vf = *(const LAS bf16x8*)(vr + (32 * dt) * VT_PITCH + 32 * s); A.o[dt] = MFMA32(vf, pf[s], A.o[dt]); }
    LDS_WAIT();
}
__device__ __forceinline__ f32x16 attn_qk(const bf16* kp, const bf16x8 (&qf)[8]) {
    f32x16 s;
#pragma unroll
    for (int r = 0; r < 16; ++r) s[r] = 0.f;
#pragma unroll
    for (int st = 0; st < 8; ++st) { const bf16x8 kf = *(const bf16x8*)(kp + 16 * st); s = MFMA32(kf, qf[st], s); }
    return s;
}
__device__ __forceinline__ int pi32(int m) { return (m & 0x13) | ((m & 4) << 1) | ((m & 8) >> 1); }
__device__ __forceinline__ void attn_init(AttnAcc& A) {
#pragma unroll
    for (int dt = 0; dt < 4; ++dt)
#pragma unroll
        for (int r = 0; r < 16; ++r) A.o[dt][r] = 0.f;
    A.m = NEGF; A.l = 0.f;
}
__device__ __forceinline__ float attn_finish(AttnAcc& A, bf16* dst, size_t rowoff  , int lane) {
    const int hi = lane >> 5;
    const float lt = A.l + __shfl_xor(A.l, 32);
    const float inv = 1.0f / lt;
#pragma unroll
    for (int dt = 0; dt < 4; ++dt)
#pragma unroll
        for (int g4 = 0; g4 < 4; ++g4) { v2u w; w.x = cvtpk(A.o[dt][4 * g4 + 0] * inv, A.o[dt][4 * g4 + 1] * inv); w.y = cvtpk(A.o[dt][4 * g4 + 2] * inv, A.o[dt][4 * g4 + 3] * inv);
            *(v2u*)(dst + rowoff + 32 * dt + 8 * g4 + 4 * hi) = w; }
    return A.m + __builtin_amdgcn_logf(lt);
}

__device__ __forceinline__ void attn_unit_a(Frame& F, int ua, LAS unsigned char* vt) {
    bf16* QKV = (bf16*)(F.ws + WS_QKV); float* LSE = (float*)(F.ws + WS_LSE);
    const int lane = F.lane, q = lane & 31, hi = lane >> 5;
    const int b = ua / 1536, rem = ua % 1536, h = rem >> 7, idx = rem & 127, g = h >> 2, dsh = 2 * g, d = 1 << dsh, tpr = 128 >> dsh, L = SEQ >> dsh;
    const int r = idx / tpr, i0 = (idx % tpr) * 32;
    const float slope2 = exp2f(-8.0f * (float)(h + 1) / 12.0f) * (float)d * LOG2E;
    const float c1 = 0.08838834764831845f * LOG2E;
    const int iq = i0 + q;
    const size_t qrow = (size_t)b * SEQ + (size_t)iq * d + r;
    bf16x8 qf[8];
#pragma unroll
    for (int st = 0; st < 8; ++st) qf[st] = *(const bf16x8*)(QKV + qrow * NQKV + h * 128 + 16 * st + 8 * hi);
    AttnAcc A; attn_init(A);
    const int jbase = i0 - 64;
    for (int t = 0; t < 5; ++t) {
        int jk = jbase + 32 * t + pi32(q); jk = jk < 0 ? 0 : (jk > L - 1 ? L - 1 : jk);
        const size_t krow = (size_t)b * SEQ + (size_t)jk * d + r;
        f32x16 s = attn_qk(QKV + krow * NQKV + 2048 + h * 128 + 8 * hi, qf);
        f32x16 s2;
#pragma unroll
        for (int rr = 0; rr < 16; ++rr) { const int j = jbase + 32 * t + 16 * (rr >> 3) + 8 * hi + (rr & 7); const int rel = j - iq, arel = rel < 0 ? -rel : rel;
            const bool valid = (arel <= 64) && (j >= 0) && (j < L);
            s2[rr] = valid ? (s[rr] * c1 - slope2 * (float)arel) : NEGF; }
        int jv = jbase + 32 * t + q; jv = jv < 0 ? 0 : (jv > L - 1 ? L - 1 : jv);
        const size_t vrow = (size_t)b * SEQ + (size_t)jv * d + r;
        attn_tile_update(A, s2, QKV, vrow, 4096 + h * 128 + 64 * hi, vt, lane);
    }
    const float lse2 = attn_finish(A, QKV, qrow * NQKV + h * 128, lane);
    if (hi == 0) LSE[qrow * 12 + h] = lse2;
}
__device__ __forceinline__ void attn_unit_b(Frame& F, int ub, LAS unsigned char* vt) {
    bf16* QKV = (bf16*)(F.ws + WS_QKV); bf16* YB = (bf16*)(F.ws + WS_YB);
    const int lane = F.lane, q = lane & 31, hi = lane >> 5;
    const int b = ub / 512, rem = ub % 512, hb = rem >> 7, rem2 = rem & 127, R = rem2 >> 1, half = rem2 & 1, h = 12 + hb;
    const float c1 = 0.08838834764831845f * LOG2E;
    const int cq = 32 * half + q;
    const size_t qrow = (size_t)b * SEQ + R * 64 + cq;
    int rs = R - 4; rs = rs < 0 ? 0 : (rs > 56 ? 56 : rs);
    int cs = cq - 8; cs = cs < 0 ? 0 : (cs > 48 ? 48 : cs);
    bf16x8 qf[8];
#pragma unroll
    for (int st = 0; st < 8; ++st) qf[st] = *(const bf16x8*)(QKV + qrow * NQKV + h * 128 + 16 * st + 8 * hi);
    AttnAcc A; attn_init(A);
    const float* rp = F.rpb + hb * (15 * 31);
    for (int t = 0; t < 16; ++t) {
        const int Rk = rs + (t >> 1), cb = 32 * (t & 1);
        const size_t krow = (size_t)b * SEQ + Rk * 64 + cb + pi32(q);
        f32x16 s = attn_qk(QKV + krow * NQKV + 2048 + h * 128 + 8 * hi, qf);
        const float* rpr = rp + (Rk - R + 7) * 31;
        f32x16 s2;
#pragma unroll
        for (int rr = 0; rr < 16; ++rr) { const int col = cb + 16 * (rr >> 3) + 8 * hi + (rr & 7);
            const bool valid = (col >= cs) && (col < cs + 16);
            int di = col - cq + 15; di = di < 0 ? 0 : (di > 30 ? 30 : di);
            const float bias = rpr[di];
            s2[rr] = valid ? (s[rr] * c1 + bias * LOG2E) : NEGF; }
        const size_t vrow = (size_t)b * SEQ + Rk * 64 + cb + q;
        attn_tile_update(A, s2, QKV, vrow, 4096 + h * 128 + 64 * hi, vt, lane);
    }
    (void)attn_finish(A, YB, qrow * 512 + hb * 128, lane);
}
__device__ __forceinline__ void attn_phase(Frame& F) {
    LAS unsigned char* vt = F.lds + F.wave * 16384;
    for (int su = F.gw; su < 2048; su += F.ngw) {
        if (su < 1024) attn_unit_b(F, su, vt);
        else { const int a0 = 3 * (su - 1024); for (int k = 0; k < 3; ++k) attn_unit_a(F, a0 + k, vt); }
    }
}
__device__ __forceinline__ void combine_phase(Frame& F) {
    const bf16* QKV = (const bf16*)(F.ws + WS_QKV); const float* LSE = (const float*)(F.ws + WS_LSE); bf16* YA = (bf16*)(F.ws + WS_YA);
    const int hg = F.lane >> 4, dc = (F.lane & 15) * 8;
    for (int m = F.gw; m < M; m += F.ngw) {
        const float l0 = LSE[(size_t)m * 12 + hg], l1 = LSE[(size_t)m * 12 + 4 + hg], l2 = LSE[(size_t)m * 12 + 8 + hg];
        const float mx = fmaxf(l0, fmaxf(l1, l2));
        float w0 = __builtin_amdgcn_exp2f(l0 - mx), w1 = __builtin_amdgcn_exp2f(l1 - mx), w2 = __builtin_amdgcn_exp2f(l2 - mx);
        const float inv = 1.0f / (w0 + w1 + w2); w0 *= inv; w1 *= inv; w2 *= inv;
        const v4u a = *(const v4u*)(QKV + (size_t)m * NQKV + (0 + hg) * 128 + dc), bq = *(const v4u*)(QKV + (size_t)m * NQKV + (4 + hg) * 128 + dc), c = *(const v4u*)(QKV + (size_t)m * NQKV + (8 + hg) * 128 + dc);
        v4u o;
        o.x = pk2(w0 * bflo(a.x) + w1 * bflo(bq.x) + w2 * bflo(c.x), w0 * bfhi(a.x) + w1 * bfhi(bq.x) + w2 * bfhi(c.x));
        o.y = pk2(w0 * bflo(a.y) + w1 * bflo(bq.y) + w2 * bflo(c.y), w0 * bfhi(a.y) + w1 * bfhi(bq.y) + w2 * bfhi(c.y));
        o.z = pk2(w0 * bflo(a.z) + w1 * bflo(bq.z) + w2 * bflo(c.z), w0 * bfhi(a.z) + w1 * bfhi(bq.z) + w2 * bfhi(c.z));
        o.w = pk2(w0 * bflo(a.w) + w1 * bflo(bq.w) + w2 * bflo(c.w), w0 * bfhi(a.w) + w1 * bfhi(bq.w) + w2 * bfhi(c.w));
        *(v4u*)(YA + (size_t)m * 512 + hg * 128 + dc) = o;
    }
}
__device__ __forceinline__ void final_phase(Frame& F) {
    const float* SS2 = (const float*)(F.ws + WS_SS2);
    for (int m = F.gw; m < M; m += F.ngw) {
        const float rstd = 1.0f / sqrtf(__hip_atomic_load(SS2 + m, __ATOMIC_RELAXED, __HIP_MEMORY_SCOPE_AGENT) * (1.0f / DM) + EPS);
        f32x4* xr = (f32x4*)(F.out + (size_t)m * DM) + F.lane;
#pragma unroll
        for (int j = 0; j < 8; ++j) { const f32x4 g = ((const f32x4*)F.norm_final)[F.lane + 64 * j]; f32x4 v = xr[64 * j]; v = v * rstd * g; xr[64 * j] = v; }
    }
}

#define GAS __attribute__((address_space(1)))
#define XB_TMO      128
#define XB_XCNT(j)  (256  + 64 * (j))
#define XB_XSUB(j)  (1280 + 64 * (j))
#define XB_XGEN(j)  (2304 + 64 * (j))
#define XB_TOP      3328
#define XB_TOPGEN   3392
#define XCD_BAR_WORDS 3456
#define XB_SPIN_CAP (1u << 18)

__device__ __forceinline__ unsigned xb_ld(unsigned* p)              { return __hip_atomic_load(p, __ATOMIC_RELAXED, __HIP_MEMORY_SCOPE_AGENT); }
__device__ __forceinline__ unsigned xb_add(unsigned* p, unsigned v) { return __hip_atomic_fetch_add(p, v, __ATOMIC_RELAXED, __HIP_MEMORY_SCOPE_AGENT); }
__device__ __forceinline__ unsigned xb_xcc_id() { return (unsigned)__builtin_amdgcn_s_getreg((3 << 11) | 20) & 0xFu; }
#define XB_SPIN(cond, bar) do { unsigned _sp = 0; while (cond) { __builtin_amdgcn_s_sleep(1); \
    if ((++_sp & 255u) == 0u) { if (xb_ld(&(bar)[XB_TMO])) break; if (_sp > XB_SPIN_CAP) { atomicAdd(&(bar)[XB_TMO], 1u); break; } } } } while (0)

struct XcdBarrier {
    unsigned* bar; unsigned x;
    volatile LAS unsigned* st;
};

__device__ __forceinline__ XcdBarrier xcd_barrier_post(unsigned* bar, volatile LAS unsigned* st) {
    XcdBarrier b; b.bar = bar; b.x = xb_xcc_id(); b.st = st;
    if (threadIdx.x == 0) (void)xb_add(&bar[XB_XCNT(b.x)], 1u);
    return b;
}
__device__ __forceinline__ void xcd_barrier_complete(unsigned* bar, unsigned x, unsigned& nloc, unsigned& nx) {
    const unsigned G = gridDim.x * gridDim.y * gridDim.z;
    unsigned sum, cnt, mine, sp = 0u;
    for (;;) {
        sum = 0u; cnt = 0u; mine = 0u;
#pragma unroll
        for (unsigned j = 0; j < 16; ++j) { const unsigned c = xb_ld(&bar[XB_XCNT(j)]); sum += c; cnt += (c > 0u) ? 1u : 0u; mine = (j == x) ? c : mine; }
        if (sum == G) break;
        __builtin_amdgcn_s_sleep(1);
        if ((++sp & 255u) == 0u) { if (xb_ld(&bar[XB_TMO])) break; if (sp > XB_SPIN_CAP) { atomicAdd(&bar[XB_TMO], 1u); break; } }
    }
    nloc = mine > 0u ? mine : 1u; nx = cnt > 0u ? cnt : 1u;
}

__device__ __forceinline__ void xcd_barrier(const XcdBarrier& b) {
    asm volatile("s_waitcnt vmcnt(0)" ::: "memory");
    __syncthreads();
    if (threadIdx.x == 0) {
        unsigned* bar = b.bar;
        __builtin_amdgcn_s_waitcnt(0);
        unsigned nloc = b.st[0], nx = b.st[1];
        if (nloc == 0u) { xcd_barrier_complete(bar, b.x, nloc, nx); b.st[0] = nloc; b.st[1] = nx; }
        const unsigned old = xb_add(&bar[XB_XSUB(b.x)], 1u);
        const unsigned gen = old / nloc;
        if (old + 1u == (gen + 1u) * nloc) {
            __builtin_amdgcn_fence(__ATOMIC_RELEASE, "agent");
            asm volatile("s_waitcnt vmcnt(0)" ::: "memory");
            const unsigned og = xb_add(&bar[XB_TOP], 1u);
            const unsigned tg = og / nx;
            if (og + 1u == (tg + 1u) * nx) xb_add(&bar[XB_TOPGEN], 1u);
            else XB_SPIN(xb_ld(&bar[XB_TOPGEN]) == tg, bar);
            __builtin_amdgcn_fence(__ATOMIC_ACQUIRE, "agent");
            xb_add(&bar[XB_XGEN(b.x)], 1u);
            asm volatile("s_waitcnt vmcnt(0)" ::: "memory");
        } else {
            XB_SPIN(xb_ld(&bar[XB_XGEN(b.x)]) == gen, bar);
            __builtin_amdgcn_fence(__ATOMIC_ACQUIRE, "agent");
            asm volatile("s_waitcnt vmcnt(0)" ::: "memory");
        }
    }
    __syncthreads();
}

constexpr int NPHASE = 9;
struct Args { const float* in[13]; float* out; unsigned char* ws; int ph_lo, ph_hi, coop, pad; };
__global__ void __launch_bounds__(NWAVES * 64, 2) mega_fwd(Args args) {
    extern __shared__ __attribute__((aligned(16))) unsigned char lds[];
    cg::grid_group grid = cg::this_grid();
    Frame F;
    F.lds = (LAS unsigned char*)lds;
    F.tid = threadIdx.x; F.lane = F.tid & 63; F.wave = __builtin_amdgcn_readfirstlane(F.tid >> 6);
    F.G = gridDim.x; F.gw = blockIdx.x * NWAVES + F.wave; F.ngw = F.G * NWAVES;
    F.x = args.in[0]; F.norm_mix = args.in[1]; F.w_qkv = args.in[2]; F.w_gate = args.in[3]; F.b_gate = args.in[4]; F.rpb = args.in[5]; F.w_pa = args.in[6]; F.w_pb = args.in[7];
    F.w_out = args.in[8]; F.norm_mlp = args.in[9]; F.w_up = args.in[10]; F.w_down = args.in[11]; F.norm_final = args.in[12];
    F.out = args.out; F.ws = args.ws;
    const int lo = args.ph_lo, hi = args.ph_hi; const bool coop = args.coop != 0;
#define IN(k) (lo <= (k) && (k) < hi)
#define SEAM(k) do { if (coop && IN((k) + 1)) xcd_barrier(bar); else { asm volatile("s_waitcnt vmcnt(0) lgkmcnt(0)" ::: "memory"); __syncthreads(); } } while (0)
    volatile LAS unsigned* MISC = (volatile LAS unsigned*)(F.lds + MISC_OFF);
    for (int u = F.tid; u < 64; u += NWAVES * 64) MISC[u] = 0u;
    __syncthreads();
    XcdBarrier bar; bar.bar = (unsigned*)(args.ws + WS_CTL); bar.x = 0; bar.st = nullptr;
    if (coop) { bar = xcd_barrier_post((unsigned*)(args.ws + WS_CTL), MISC + 8); grid.sync(); }
    unsigned char* ws = args.ws;
    typedef pg8::bf16_t pb;
    if (IN(0)) { p0_prologue(F); SEAM(0); }
    if (IN(1)) {
        pg8::Gemm g{(const pb*)(ws + WS_H), (const pb*)(ws + WS_W1T), M, N1, DM}; pg8::StaticOrder S; S.init(M, N1, F.G, (int)blockIdx.x);
        pg8::EpiQkvGate E{(pb*)(ws + WS_QKV), (pb*)(ws + WS_G), F.b_gate};
        pg8::gemm_phase<pg8::EpiQkvGate, pg8::StaticOrder, true, true>(F.lds, g, S, E);
        SEAM(1);
    }
    if (IN(2)) { attn_phase(F); SEAM(2); }
    if (IN(3)) { combine_phase(F); convert_updown(F); SEAM(3); }
    if (IN(4)) {
        { pg8::Gemm g{(const pb*)(ws + WS_YB), (const pb*)(ws + WS_WPB), M, DM, WA}; pg8::StaticOrder S; S.init(M, DM, F.G, (int)blockIdx.x);
          pg8::EpiProj<true> E{(const pb*)(ws + WS_G), 2048, (pb*)(ws + WS_T), (pb*)(ws + WS_MG)};
          pg8::gemm_phase<pg8::EpiProj<true>, pg8::StaticOrder, true, true>(F.lds, g, S, E); }
        __syncthreads();
#ifndef PROBE_SKIP_PA
        { pg8::Gemm g{(const pb*)(ws + WS_YA), (const pb*)(ws + WS_WPA), M, DM, WA}; pg8::StaticOrder S; S.init(M, DM, F.G, (int)blockIdx.x);
          pg8::EpiProj<false> E{(const pb*)(ws + WS_G), 0, (pb*)(ws + WS_T), (pb*)(ws + WS_MG)};
          pg8::gemm_phase<pg8::EpiProj<false>, pg8::StaticOrder, true, true>(F.lds, g, S, E); }
#endif
        SEAM(4);
    }
    if (IN(5)) {
        pg8::Gemm g{(const pb*)(ws + WS_MG), (const pb*)(ws + WS_WOUT), M, DM, DM}; pg8::StaticOrder S; S.init(M, DM, F.G, (int)blockIdx.x);
        pg8::EpiOut E{F.x, F.out, (pb*)(ws + WS_XG2), F.norm_mlp, (float*)(ws + WS_SS1)};
        pg8::gemm_phase<pg8::EpiOut, pg8::StaticOrder, true, true>(F.lds, g, S, E);
        SEAM(5);
    }
    if (IN(6)) {
        pg8::Gemm g{(const pb*)(ws + WS_XG2), (const pb*)(ws + WS_WUPT), M, DFF, DM}; pg8::StaticOrder S; S.init(M, DFF, F.G, (int)blockIdx.x);
        pg8::EpiUp E{(pb*)(ws + WS_HM), (const float*)(ws + WS_SS1)};
        pg8::gemm_phase<pg8::EpiUp, pg8::StaticOrder, true, true>(F.lds, g, S, E);
        SEAM(6);
    }
    if (IN(7)) {
        pg8::Gemm g{(const pb*)(ws + WS_HM), (const pb*)(ws + WS_WDNT), M, DM, DFF}; pg8::StaticOrder S; S.init(M, DM, F.G, (int)blockIdx.x);
        pg8::EpiDown E{F.out, (float*)(ws + WS_SS2)};
        pg8::gemm_phase<pg8::EpiDown, pg8::StaticOrder, true, true>(F.lds, g, S, E);
        SEAM(7);
    }
    if (IN(8)) { final_phase(F); }
#undef IN
#undef SEAM
}

__global__ void dump_bf16(const unsigned short* src, float* dst, int n) { for (int i = blockIdx.x * blockDim.x + threadIdx.x; i < n; i += gridDim.x * blockDim.x) dst[i] = __uint_as_float((unsigned)src[i] << 16); }
#ifndef MK_N_LAUNCHES
#define MK_N_LAUNCHES 1
#endif
extern "C" void kernel_launch(void* const* d_in, const int* in_sizes, int n_in, void* d_out, int out_size, void* d_ws, size_t ws_size, hipStream_t stream) {
    static int grid = 0;
    if (grid == 0) {
        if (n_in != 13 || out_size != M * DM || ws_size < WS_END) { fprintf(stderr, "kernel_launch: unexpected shapes (n_in %d out %d ws %zu need %zu)\n", n_in, out_size, ws_size, (size_t)WS_END); grid = -1; return; }
        int dev = 0, cus = 0, per_cu = 0;
        hipGetDevice(&dev); hipDeviceGetAttribute(&cus, hipDeviceAttributeMultiprocessorCount, dev);
        hipFuncSetAttribute((const void*)mega_fwd, hipFuncAttributeMaxDynamicSharedMemorySize, LDS_BYTES);
        hipOccupancyMaxActiveBlocksPerMultiprocessor(&per_cu, (const void*)mega_fwd, NWAVES * 64, LDS_BYTES);
        (void)hipGetLastError();
        if (per_cu < 1) per_cu = 1;
        grid = cus;
    }
    if (grid < 0) return;
    Args a{};
    for (int i = 0; i < 13; ++i) a.in[i] = (const float*)d_in[i];
    a.out = (float*)d_out; a.ws = (unsigned char*)d_ws;
#if MK_N_LAUNCHES == 1
    if (hipMemsetAsync((char*)d_ws + WS_CTL, 0, CTL_ZERO_BYTES, stream) != hipSuccess) { fprintf(stderr, "memset failed\n"); return; }
    a.ph_lo = 0; a.ph_hi = NPHASE; a.coop = 1;
    void* kargs[] = {&a};
    hipError_t e = hipLaunchCooperativeKernel((const void*)mega_fwd, dim3(grid), dim3(NWAVES * 64), kargs, LDS_BYTES, stream);
    if (e != hipSuccess) fprintf(stderr, "cooperative launch failed: %s (grid %d)\n", hipGetErrorString(e), grid);
#else
#ifndef PROBE_STOP
#define PROBE_STOP NPHASE
#endif
    for (int p = 0; p < PROBE_STOP; ++p) {
        a.ph_lo = p; a.ph_hi = p + 1; a.coop = 0;
        hipLaunchKernelGGL(mega_fwd, dim3(grid), dim3(NWAVES * 64), LDS_BYTES, stream, a);
    }
#ifdef PROBE_DUMP_OFF
    hipLaunchKernelGGL(dump_bf16, dim3(2048), dim3(256), 0, stream, (const unsigned short*)((char*)d_ws + PROBE_DUMP_OFF), (float*)d_out, M * DM);
#endif
#endif
}
```

```cpp
#include <hip/hip_runtime.h>
#include <hip/hip_cooperative_groups.h>
#include <cstdio>
#include <cstdint>
namespace cg = cooperative_groups;
namespace pg8 {
#define PG8_LAS __attribute__((address_space(3)))
typedef unsigned short bf16_t;
typedef short bf16x8 __attribute__((ext_vector_type(8)));
typedef float f32x4 __attribute__((ext_vector_type(4)));
typedef unsigned u32x4 __attribute__((ext_vector_type(4)));
constexpr int BM = 256, BK = 64, HALF = 128, HTB = HALF * BK * 2  , STAGE_BYTES = 8 * HTB, NXCD = 8, WGM = 8;

__host__ __device__ __forceinline__ int lds_byte(int r, int c) { const int st = (r >> 4) * 2 + (c >> 5), rr = r & 15, cc = c & 31, ob = rr * 64 + cc * 2; return st * 1024 + (ob ^ (((ob >> 9) & 1) << 5)); }
__host__ __device__ __forceinline__ void stage_rc(int b, int& R, int& C) { const int st = b / 1024, sb = b % 1024, swz = sb ^ (((sb >> 9) & 1) << 5); R = (st >> 1) * 16 + swz / 64; C = (st & 1) * 32 + (swz % 64) / 2; }
__host__ __device__ __forceinline__ int perm32(int rho) { const int n = rho >> 4, i = rho & 15; return 8 * (i >> 2) + 4 * n + (i & 3); }

struct Unit { int pm, pn; };
struct Gemm { const bf16_t* A; const bf16_t* Bt; int M, N, K; };

struct StaticOrder {
    int nM, nN, nwg, G, c;
    __host__ __device__ void init(int M, int N, int G_, int c_) { nM = M / BM; nN = N / BM; nwg = nM * nN; G = G_; c = c_; }
    __host__ __device__ bool next(int i, Unit& u) const {
        const long L = (long)i * G + c; if (L >= nwg) return false;
        int wgid = (int)L; { const int q = nwg / NXCD, r = nwg % NXCD, xcd = wgid % NXCD, off = wgid / NXCD; wgid = (xcd < r ? xcd * (q + 1) : r * (q + 1) + (xcd - r) * q) + off; }
        const int nig = WGM * nN, gid = wgid / nig, fm = gid * WGM, gsz = (nM - fm) < WGM ? (nM - fm) : WGM;
        u.pm = fm + ((wgid % nig) % gsz); u.pn = (wgid % nig) / gsz; return true;
    }
    __device__ __forceinline__ void a_ready(const Unit&) const {}
    __device__ __forceinline__ void done(const Unit&) const {}
};
typedef __bf16 pg8_bf16x2 __attribute__((ext_vector_type(2)));
typedef float pg8_f32x2 __attribute__((ext_vector_type(2)));
__device__ __forceinline__ unsigned cvt_pk_bf16(float lo, float hi) { pg8_f32x2 v = {lo, hi}; pg8_bf16x2 b = __builtin_convertvector(v, pg8_bf16x2); return __builtin_bit_cast(unsigned, b); }
__device__ __forceinline__ u32x4 pack8(const f32x4 v0, const f32x4 v1) { u32x4 w; w.x = cvt_pk_bf16(v0[0], v0[1]); w.y = cvt_pk_bf16(v0[2], v0[3]); w.z = cvt_pk_bf16(v1[0], v1[1]); w.w = cvt_pk_bf16(v1[2], v1[3]); return w; }
__device__ __forceinline__ void unpack8(const u32x4 w, f32x4& v0, f32x4& v1) {
    v0[0] = __uint_as_float(w.x << 16); v0[1] = __uint_as_float(w.x & 0xffff0000u); v0[2] = __uint_as_float(w.y << 16); v0[3] = __uint_as_float(w.y & 0xffff0000u);
    v1[0] = __uint_as_float(w.z << 16); v1[1] = __uint_as_float(w.z & 0xffff0000u); v1[2] = __uint_as_float(w.w << 16); v1[3] = __uint_as_float(w.w & 0xffff0000u); }
__device__ __forceinline__ float sigmoidf_fast(float x) { return __builtin_amdgcn_rcpf(1.0f + __expf(-x)); }

struct EpiQkvGate {
    static constexpr bool PERM = true, AFTER_DRAIN = false;
    bf16_t* QKV; bf16_t* G; const float* bgate;
    __device__ __forceinline__ void operator()(const f32x4 (&acc)[2][2][4][2], const Unit& u, int wr, int wc, int fr, int fq) const {
        const int row0 = u.pm * BM + wr * 64 + fr, colt = u.pn * BM, cw = wc * 32 + 8 * fq;
        if (colt < 6144) {
#pragma unroll
            for (int ai = 0; ai < 2; ++ai)
#pragma unroll
                for (int m = 0; m < 4; ++m) { bf16_t* rowp = QKV + (size_t)(row0 + ai * HALF + m * 16) * 6144 + colt + cw;
#pragma unroll
                    for (int bj = 0; bj < 2; ++bj) *(u32x4*)(rowp + bj * HALF) = pack8(acc[ai][bj][m][0], acc[ai][bj][m][1]); }
        } else {
            const int gc = colt - 6144 + cw;
            f32x4 bv[2][2];
#pragma unroll
            for (int bj = 0; bj < 2; ++bj)
#pragma unroll
                for (int n = 0; n < 2; ++n) bv[bj][n] = *(const f32x4*)(bgate + gc + bj * HALF + 4 * n);
#pragma unroll
            for (int ai = 0; ai < 2; ++ai)
#pragma unroll
                for (int m = 0; m < 4; ++m) { bf16_t* rowp = G + (size_t)(row0 + ai * HALF + m * 16) * 4096 + gc;
#pragma unroll
                    for (int bj = 0; bj < 2; ++bj) { f32x4 v0 = acc[ai][bj][m][0] + bv[bj][0], v1 = acc[ai][bj][m][1] + bv[bj][1];
#pragma unroll
                        for (int e = 0; e < 4; ++e) { v0[e] = sigmoidf_fast(v0[e]); v1[e] = sigmoidf_fast(v1[e]); }
                        *(u32x4*)(rowp + bj * HALF) = pack8(v0, v1); } }
        }
    }
};
template <bool FIRST> struct EpiProj {
    static constexpr bool PERM = true, AFTER_DRAIN = false;
    const bf16_t* G; int goff; bf16_t* T; bf16_t* O;
    __device__ __forceinline__ void operator()(const f32x4 (&acc)[2][2][4][2], const Unit& u, int wr, int wc, int fr, int fq) const {
        const int row0 = u.pm * BM + wr * 64 + fr, col0 = u.pn * BM + wc * 32 + 8 * fq;
#pragma unroll
        for (int ai = 0; ai < 2; ++ai)
#pragma unroll
            for (int m = 0; m < 4; ++m) { const size_t row = (size_t)(row0 + ai * HALF + m * 16);
#pragma unroll
                for (int bj = 0; bj < 2; ++bj) { const int col = col0 + bj * HALF;
                    f32x4 g0, g1; unpack8(*(const u32x4*)(G + row * 4096 + goff + col), g0, g1);
                    f32x4 v0 = acc[ai][bj][m][0] * g0, v1 = acc[ai][bj][m][1] * g1;
                    if (!FIRST) { f32x4 t0, t1; unpack8(*(const u32x4*)(T + row * 2048 + col), t0, t1); v0 += t0; v1 += t1; }
                    *(u32x4*)((FIRST ? T : O) + row * 2048 + col) = pack8(v0, v1); } }
    }
};
struct EpiOut {
    static constexpr bool PERM = true, AFTER_DRAIN = false;
    const float* X; float* X1; bf16_t* XG; const float* gmlp; float* SS;
    __device__ __forceinline__ void operator()(const f32x4 (&acc)[2][2][4][2], const Unit& u, int wr, int wc, int fr, int fq) const {
        const int row0 = u.pm * BM + wr * 64 + fr, col0 = u.pn * BM + wc * 32 + 8 * fq;
        f32x4 gv[2][2];
#pragma unroll
        for (int bj = 0; bj < 2; ++bj)
#pragma unroll
            for (int n = 0; n < 2; ++n) gv[bj][n] = *(const f32x4*)(gmlp + col0 + bj * HALF + 4 * n);
#pragma unroll
        for (int ai = 0; ai < 2; ++ai)
#pragma unroll
            for (int m = 0; m < 4; ++m) { const size_t row = (size_t)(row0 + ai * HALF + m * 16); float ss = 0.f;
#pragma unroll
                for (int bj = 0; bj < 2; ++bj) { const size_t off = row * 2048 + col0 + bj * HALF;
                    const f32x4 x0 = *(const f32x4*)(X + off), x1 = *(const f32x4*)(X + off + 4);
                    const f32x4 v0 = acc[ai][bj][m][0] + x0, v1 = acc[ai][bj][m][1] + x1;
                    *(f32x4*)(X1 + off) = v0; *(f32x4*)(X1 + off + 4) = v1;
                    ss += (v0[0] * v0[0] + v0[1] * v0[1]) + (v0[2] * v0[2] + v0[3] * v0[3]) + (v1[0] * v1[0] + v1[1] * v1[1]) + (v1[2] * v1[2] + v1[3] * v1[3]);
                    *(u32x4*)(XG + off) = pack8(v0 * gv[bj][0], v1 * gv[bj][1]); }
                ss += __shfl_xor(ss, 16); ss += __shfl_xor(ss, 32);
                if (fq == 0) __hip_atomic_fetch_add(SS + row, ss, __ATOMIC_RELAXED, __HIP_MEMORY_SCOPE_AGENT); }
    }
};
struct EpiUp {
    static constexpr bool PERM = true, AFTER_DRAIN = false;
    bf16_t* H; const float* SS;
    __device__ __forceinline__ void operator()(const f32x4 (&acc)[2][2][4][2], const Unit& u, int wr, int wc, int fr, int fq) const {
        const int row0 = u.pm * BM + wr * 64 + fr, col0 = u.pn * BM + wc * 32 + 8 * fq;
#pragma unroll
        for (int ai = 0; ai < 2; ++ai)
#pragma unroll
            for (int m = 0; m < 4; ++m) { const size_t row = (size_t)(row0 + ai * HALF + m * 16);
                const float rs = __builtin_amdgcn_rsqf(__hip_atomic_load(SS + row, __ATOMIC_RELAXED, __HIP_MEMORY_SCOPE_AGENT) * (1.0f / 2048.0f) + 1e-6f);
#pragma unroll
                for (int bj = 0; bj < 2; ++bj) { f32x4 v0 = acc[ai][bj][m][0] * rs, v1 = acc[ai][bj][m][1] * rs;
#pragma unroll
                    for (int e = 0; e < 4; ++e) { const float a = fmaxf(v0[e], 0.f), b = fmaxf(v1[e], 0.f); v0[e] = a * a; v1[e] = b * b; }
                    *(u32x4*)(H + row * 8192 + col0 + bj * HALF) = pack8(v0, v1); } }
    }
};
struct EpiDown {
    static constexpr bool PERM = true, AFTER_DRAIN = false;
    float* X1; float* SS;
    __device__ __forceinline__ void operator()(const f32x4 (&acc)[2][2][4][2], const Unit& u, int wr, int wc, int fr, int fq) const {
        const int row0 = u.pm * BM + wr * 64 + fr, col0 = u.pn * BM + wc * 32 + 8 * fq;
#pragma unroll
        for (int ai = 0; ai < 2; ++ai)
#pragma unroll
            for (int m = 0; m < 4; ++m) { const size_t row = (size_t)(row0 + ai * HALF + m * 16); float ss = 0.f;
#pragma unroll
                for (int bj = 0; bj < 2; ++bj) { const size_t off = row * 2048 + col0 + bj * HALF;
                    const f32x4 x0 = *(const f32x4*)(X1 + off), x1 = *(const f32x4*)(X1 + off + 4);
                    const f32x4 v0 = acc[ai][bj][m][0] + x0, v1 = acc[ai][bj][m][1] + x1;
                    *(f32x4*)(X1 + off) = v0; *(f32x4*)(X1 + off + 4) = v1;
                    ss += (v0[0] * v0[0] + v0[1] * v0[1]) + (v0[2] * v0[2] + v0[3] * v0[3]) + (v1[0] * v1[0] + v1[1] * v1[1]) + (v1[2] * v1[2] + v1[3] * v1[3]); }
                ss += __shfl_xor(ss, 16); ss += __shfl_xor(ss, 32);
                if (fq == 0) __hip_atomic_fetch_add(SS + row, ss, __ATOMIC_RELAXED, __HIP_MEMORY_SCOPE_AGENT); }
    }
};
template <class Epi, class Sched, bool ALIGN_EPI = false, bool SP2 = false>
__device__ __forceinline__ void gemm_phase(PG8_LAS unsigned char* lds, const Gemm g, const Sched& S, const Epi& E) {
    const int tid = threadIdx.x, wid = __builtin_amdgcn_readfirstlane(tid >> 6), lane = tid & 63, wr = wid >> 2, wc = wid & 3, fr = lane & 15, fq = lane >> 4;
    const int K = g.K, nt = K / BK;
    unsigned voffA[2], voffB[2];
#pragma unroll
    for (int i = 0; i < 2; ++i) { int R, C; stage_rc(tid * 16 + i * 8192, R, C); const int Rb = Epi::PERM ? ((R & ~31) + perm32(R & 31)) : R;
        voffA[i] = (unsigned)(R * K + C) * 2u; voffB[i] = (unsigned)(Rb * K + C) * 2u; }
    const size_t kstep = (size_t)(BK * 2);
    const size_t hstep = (size_t)HALF * K * 2;
    const size_t tstep = 2 * hstep;
    const unsigned ldsw = (unsigned)wid * 1024u;
    const int aoff = lds_byte(wr * 64 + fr, fq * 8), boff = lds_byte(wc * 32 + fr, fq * 8);
#define PG8_SA(b, h) (((b) * 2 + (h)) * HTB)
#define PG8_SB(b, h) ((4 + (b) * 2 + (h)) * HTB)
#define PG8_STAGE(bufoff, gbase, voff) do { _Pragma("unroll") for (int _i = 0; _i < 2; ++_i) \
        __builtin_amdgcn_global_load_lds((const unsigned*)((const char*)(gbase) + (voff)[_i]), (PG8_LAS unsigned*)(lds + (bufoff) + ldsw + _i * 8192), 16, 0, 0); } while (0)
#define PG8_LDA(dst, b, h) do { _Pragma("unroll") for (int m = 0; m < 4; ++m) _Pragma("unroll") for (int k = 0; k < 2; ++k) dst[m][k] = *(const PG8_LAS bf16x8*)(lds + PG8_SA(b, h) + aoff + m * 2048 + k * 1024); } while (0)
#define PG8_LDB(dst, b, h) do { _Pragma("unroll") for (int n = 0; n < 2; ++n) _Pragma("unroll") for (int k = 0; k < 2; ++k) dst[n][k] = *(const PG8_LAS bf16x8*)(lds + PG8_SB(b, h) + boff + n * 2048 + k * 1024); } while (0)
#define PG8_MMA(ai, bj, At, Bt) do { __builtin_amdgcn_s_setprio(1); _Pragma("unroll") for (int m = 0; m < 4; ++m) _Pragma("unroll") for (int n = 0; n < 2; ++n) _Pragma("unroll") for (int k = 0; k < 2; ++k) \
        acc[ai][bj][m][n] = __builtin_amdgcn_mfma_f32_16x16x32_bf16(Bt[n][k], At[m][k], acc[ai][bj][m][n], 0, 0, 0); __builtin_amdgcn_s_setprio(0); } while (0)
#define PG8_WAIT_V(n) asm volatile("s_waitcnt vmcnt(" #n ")" ::: "memory")
#define PG8_WAIT_L(n) asm volatile("s_waitcnt lgkmcnt(" #n ")" ::: "memory")
#define PG8_BAR __builtin_amdgcn_s_barrier()
#define PG8_SCHED __builtin_amdgcn_sched_barrier(0)
    Unit cur, nxt; int ui = 0;
    if (!S.next(0, cur)) return;
    f32x4 acc[2][2][4][2];
#pragma unroll
    for (int a = 0; a < 2; ++a)
#pragma unroll
        for (int b = 0; b < 2; ++b)
#pragma unroll
            for (int m = 0; m < 4; ++m)
#pragma unroll
                for (int n = 0; n < 2; ++n) acc[a][b][m][n] = (f32x4){0.f, 0.f, 0.f, 0.f};
    bf16x8 At[4][2], B0[2][2], B1[2][2];
    const char* cA = (const char*)g.A + (size_t)cur.pm * tstep; const char* cB = (const char*)g.Bt + (size_t)cur.pn * tstep;
    S.a_ready(cur);
    if constexpr (SP2) {
        PG8_STAGE(PG8_SB(0, 0), cB, voffB); PG8_STAGE(PG8_SB(0, 1), cB + hstep, voffB); PG8_STAGE(PG8_SA(0, 0), cA, voffA); PG8_STAGE(PG8_SA(0, 1), cA + hstep, voffA);
        if (wr == 1) PG8_BAR;
        PG8_WAIT_V(2); PG8_BAR;
        PG8_STAGE(PG8_SB(1, 0), cB + kstep, voffB); PG8_STAGE(PG8_SA(1, 0), cA + kstep, voffA); PG8_STAGE(PG8_SB(1, 1), cB + hstep + kstep, voffB);
        PG8_WAIT_V(6); PG8_BAR;
    } else {
        PG8_STAGE(PG8_SB(0, 0), cB, voffB); PG8_STAGE(PG8_SA(0, 0), cA, voffA); PG8_STAGE(PG8_SB(0, 1), cB + hstep, voffB); PG8_STAGE(PG8_SA(0, 1), cA + hstep, voffA);
        if (wr == 1) PG8_BAR;
        PG8_WAIT_V(4); PG8_BAR;
        PG8_STAGE(PG8_SB(1, 0), cB + kstep, voffB); PG8_STAGE(PG8_SA(1, 0), cA + kstep, voffA); PG8_STAGE(PG8_SB(1, 1), cB + hstep + kstep, voffB);
        PG8_WAIT_V(6); PG8_BAR;
    }
    for (;;) {
        const bool has_next = S.next(ui + 1, nxt);
        const char* nA = has_next ? (const char*)g.A + (size_t)nxt.pm * tstep : cA; const char* nB = has_next ? (const char*)g.Bt + (size_t)nxt.pn * tstep : cB;
        for (int t = 0; t < nt; t += 2) {
            const bool last = (t == nt - 2);
            const char* a1 = cA + (size_t)(t + 1) * kstep;
            const char* a2 = last ? nA : cA + (size_t)(t + 2) * kstep; const char* b2 = last ? nB : cB + (size_t)(t + 2) * kstep;
            const char* a3 = a2 + kstep; const char* b3 = b2 + kstep;
            if (last && has_next) S.a_ready(nxt);
            if constexpr (SP2) {
            PG8_LDB(B0, 0, 0); PG8_LDB(B1, 0, 1); PG8_SCHED; PG8_LDA(At, 0, 0); PG8_STAGE(PG8_SA(1, 1), a1 + hstep, voffA);
            PG8_WAIT_V(8); PG8_WAIT_L(0); PG8_BAR; PG8_MMA(0, 0, At, B0); PG8_MMA(0, 1, At, B1); PG8_BAR; PG8_SCHED;
            PG8_LDA(At, 0, 1); PG8_STAGE(PG8_SB(0, 0), b2, voffB); PG8_STAGE(PG8_SB(0, 1), b2 + hstep, voffB); PG8_STAGE(PG8_SA(0, 0), a2, voffA);
            PG8_WAIT_V(8); PG8_WAIT_L(0); PG8_BAR; PG8_MMA(1, 0, At, B0); PG8_MMA(1, 1, At, B1); PG8_BAR; PG8_SCHED;
            PG8_LDB(B0, 1, 0); PG8_LDB(B1, 1, 1); PG8_SCHED; PG8_LDA(At, 1, 0); PG8_STAGE(PG8_SA(0, 1), a2 + hstep, voffA);
            PG8_WAIT_V(8); PG8_WAIT_L(0); PG8_BAR; PG8_MMA(0, 0, At, B0); PG8_MMA(0, 1, At, B1); PG8_BAR; PG8_SCHED;
            PG8_LDA(At, 1, 1); PG8_STAGE(PG8_SB(1, 0), b3, voffB); PG8_STAGE(PG8_SB(1, 1), b3 + hstep, voffB); PG8_STAGE(PG8_SA(1, 0), a3, voffA);
            PG8_WAIT_V(8); PG8_WAIT_L(0); PG8_BAR; PG8_MMA(1, 0, At, B0); PG8_MMA(1, 1, At, B1); PG8_BAR; PG8_SCHED;
            } else {
            PG8_LDB(B0, 0, 0); PG8_SCHED; PG8_LDA(At, 0, 0); PG8_STAGE(PG8_SA(1, 1), a1 + hstep, voffA);
            PG8_WAIT_L(8); PG8_BAR; PG8_WAIT_L(0); PG8_MMA(0, 0, At, B0); PG8_BAR; PG8_SCHED;
            PG8_LDB(B1, 0, 1); PG8_STAGE(PG8_SB(0, 0), b2, voffB);
            PG8_BAR; PG8_WAIT_L(0); PG8_MMA(0, 1, At, B1); PG8_BAR;
            PG8_LDA(At, 0, 1); PG8_STAGE(PG8_SA(0, 0), a2, voffA);
            PG8_BAR; PG8_WAIT_L(0); PG8_MMA(1, 0, At, B0); PG8_BAR; PG8_SCHED;
            PG8_STAGE(PG8_SB(0, 1), b2 + hstep, voffB);
            PG8_WAIT_V(6); PG8_BAR; PG8_MMA(1, 1, At, B1); PG8_BAR;
            PG8_LDB(B0, 1, 0); PG8_SCHED; PG8_LDA(At, 1, 0); PG8_STAGE(PG8_SA(0, 1), a2 + hstep, voffA);
            PG8_WAIT_L(8); PG8_BAR; PG8_WAIT_L(0); PG8_MMA(0, 0, At, B0); PG8_BAR; PG8_SCHED;
            PG8_LDB(B1, 1, 1); PG8_STAGE(PG8_SB(1, 0), b3, voffB);
            PG8_BAR; PG8_WAIT_L(0); PG8_MMA(0, 1, At, B1); PG8_BAR;
            PG8_LDA(At, 1, 1); PG8_STAGE(PG8_SA(1, 0), a3, voffA);
            PG8_BAR; PG8_WAIT_L(0); PG8_MMA(1, 0, At, B0); PG8_BAR; PG8_SCHED;
            PG8_STAGE(PG8_SB(1, 1), b3 + hstep, voffB);
            PG8_WAIT_V(6); PG8_BAR; PG8_MMA(1, 1, At, B1); PG8_BAR;
            }
        }
        if constexpr (ALIGN_EPI) { if (wr == 0) PG8_BAR; }
        if constexpr (!Epi::AFTER_DRAIN) { E(acc, cur, wr, wc, fr, fq); S.done(cur); }
        if (!has_next) break;
#pragma unroll
        for (int a = 0; a < 2; ++a)
#pragma unroll
            for (int b = 0; b < 2; ++b)
#pragma unroll
                for (int m = 0; m < 4; ++m)
#pragma unroll
                    for (int n = 0; n < 2; ++n) acc[a][b][m][n] = (f32x4){0.f, 0.f, 0.f, 0.f};
        cur = nxt; cA = nA; cB = nB; ++ui;
        if constexpr (ALIGN_EPI) { if (wr == 1) PG8_BAR; }
    }
    PG8_WAIT_V(0);
    if constexpr (!ALIGN_EPI) { if (wr == 0) PG8_BAR; }
    PG8_BAR;
    if constexpr (Epi::AFTER_DRAIN) { E.fused(acc, cur, wr, wc, fr, fq, lds, wid, lane); S.done(cur); }
#undef PG8_SA
#undef PG8_SB
#undef PG8_STAGE
#undef PG8_LDA
#undef PG8_LDB
#undef PG8_MMA
#undef PG8_WAIT_V
#undef PG8_WAIT_L
#undef PG8_BAR
#undef PG8_SCHED
}
}

constexpr int NWAVES = 8;
constexpr int SEQ = 4096, DM = 2048, M = 2 * SEQ, NQKV = 6144, NG = 4096, N1 = NQKV + NG, DFF = 8192, WA = 512;
constexpr float EPS = 1e-6f, LOG2E = 1.4426950408889634f;
constexpr size_t MiB = 1u << 20;
constexpr size_t WS_SS1 = 0, WS_SS2 = 32768, WS_LSE = 65536;
constexpr size_t WS_WPA = 1 * MiB, WS_WPB = 3 * MiB, WS_WOUT = 5 * MiB;
constexpr size_t WS_YA = 13 * MiB, WS_YB = 21 * MiB;
constexpr size_t WS_RA = 29 * MiB;
constexpr size_t WS_H = WS_RA, WS_W1T = WS_RA + 32 * MiB, WS_WUPT = WS_RA, WS_WDNT = WS_RA + 32 * MiB;
constexpr size_t WS_RB = 101 * MiB;
constexpr size_t WS_QKV = WS_RB, WS_G = WS_RB + 96 * MiB;
constexpr size_t WS_T = WS_RB, WS_MG = WS_RB + 32 * MiB;
constexpr size_t WS_HM = WS_RB;
constexpr size_t WS_XG2 = WS_RB + 128 * MiB;
constexpr size_t WS_OA = WS_RB + 160 * MiB;
constexpr size_t WS_END = WS_OA + 24 * MiB;

constexpr size_t WS_CTL = 512 * 1024, CTL_ZERO_BYTES = 16384;
constexpr int MISC_OFF = 147456;
constexpr int LDS_BYTES = 147456 + 1024;

#define LAS __attribute__((address_space(3)))
typedef unsigned short bf16;
typedef unsigned v4u __attribute__((ext_vector_type(4)));
typedef unsigned v2u __attribute__((ext_vector_type(2)));
typedef float f32x4 __attribute__((ext_vector_type(4)));
typedef float f32x16 __attribute__((ext_vector_type(16)));
typedef short bf16x8 __attribute__((ext_vector_type(8)));
#define LDS_WAIT() asm volatile("s_waitcnt lgkmcnt(0)" ::: "memory")
__device__ __forceinline__ unsigned f2bf(float f) { unsigned u = __builtin_bit_cast(unsigned, f); return (u + 0x7fffu + ((u >> 16) & 1u)) >> 16; }
__device__ __forceinline__ unsigned pk2(float lo, float hi) { return f2bf(lo) | (f2bf(hi) << 16); }
__device__ __forceinline__ float bflo(unsigned w) { return __uint_as_float(w << 16); }
__device__ __forceinline__ float bfhi(unsigned w) { return __uint_as_float(w & 0xffff0000u); }
__device__ __forceinline__ float wave_sum(float v) {
#pragma unroll
    for (int o = 1; o < 64; o <<= 1) v += __shfl_xor(v, o);
    return v;
}

struct Frame {
    LAS unsigned char* lds;
    int tid, lane, wave, G, gw, ngw;
    const float *x, *norm_mix, *w_qkv, *w_gate, *b_gate, *rpb, *w_pa, *w_pb, *w_out, *norm_mlp, *w_up, *w_down, *norm_final;
    float* out; unsigned char* ws;
};

__device__ __forceinline__ void transpose_item(const float* W, int K, int N, bf16* WT, int row_off, LAS float* scr, int item, int lane) {
    const int nblk = N / 32, kb = item / nblk, nb = item % nblk, k0 = 64 * kb, n0 = 32 * nb;
#pragma unroll 8
    for (int i = 0; i < 32; ++i) { const int kk = 2 * i + (lane >> 5); scr[kk * 33 + (lane & 31)] = W[(size_t)(k0 + kk) * N + n0 + (lane & 31)]; }
    LDS_WAIT(); asm volatile("" ::: "memory");
    const int c = lane & 7;
#pragma unroll
    for (int j = 0; j < 4; ++j) { const int n = (lane >> 3) + 8 * j; const LAS float* s = scr + (8 * c) * 33 + n;
        v4u o; o.x = pk2(s[0 * 33], s[1 * 33]); o.y = pk2(s[2 * 33], s[3 * 33]); o.z = pk2(s[4 * 33], s[5 * 33]); o.w = pk2(s[6 * 33], s[7 * 33]);
        *(v4u*)(WT + (size_t)(row_off + n0 + n) * K + k0 + 8 * c) = o; }
    LDS_WAIT(); asm volatile("" ::: "memory");
}

__device__ __forceinline__ void p0_prologue(Frame& F) {
    LAS float* scr = (LAS float*)(F.lds + F.wave * 18432);
    bf16* W1t = (bf16*)(F.ws + WS_W1T);
    constexpr int I_QKV = (DM / 64) * (NQKV / 32), I_G = (DM / 64) * (NG / 32);
    for (int it = F.gw; it < I_QKV + I_G; it += F.ngw) {
        if (it < I_QKV) transpose_item(F.w_qkv, DM, NQKV, W1t, 0, scr, it, F.lane);
        else transpose_item(F.w_gate, DM, NG, W1t, NQKV, scr, it - I_QKV, F.lane);
    }
    bf16* H = (bf16*)(F.ws + WS_H);
    for (int m = F.gw; m < M; m += F.ngw) {
        const f32x4* xr = (const f32x4*)(F.x + (size_t)m * DM) + F.lane;
        f32x4 v[8]; float s = 0.f;
#pragma unroll
        for (int j = 0; j < 8; ++j) { v[j] = xr[64 * j]; s += (v[j].x * v[j].x + v[j].y * v[j].y) + (v[j].z * v[j].z + v[j].w * v[j].w); }
        const float rstd = 1.0f / sqrtf(wave_sum(s) * (1.0f / DM) + EPS);
        v2u* o8 = (v2u*)(H + (size_t)m * DM) + F.lane;
#pragma unroll
        for (int j = 0; j < 8; ++j) { const f32x4 g = ((const f32x4*)F.norm_mix)[F.lane + 64 * j]; v2u o; o.x = pk2(v[j].x * rstd * g.x, v[j].y * rstd * g.y); o.y = pk2(v[j].z * rstd * g.z, v[j].w * rstd * g.w); o8[64 * j] = o; }
    }
    float* ss = (float*)(F.ws + WS_SS1);
    for (int i = blockIdx.x * 512 + F.tid; i < 16384; i += F.G * 512) ss[i] = 0.f;
}

__device__ __forceinline__ void convert_updown(Frame& F) {
    LAS float* scr = (LAS float*)(F.lds + F.wave * 18432);
    constexpr int I_U = (DM / 64) * (DFF / 32), I_D = (DFF / 64) * (DM / 32), I_P = (WA / 64) * (DM / 32), I_O = (DM / 64) * (DM / 32);
    for (int it = F.gw; it < I_U + I_D + 2 * I_P + I_O; it += F.ngw) {
        int r = it;
        if (r < I_U) { transpose_item(F.w_up, DM, DFF, (bf16*)(F.ws + WS_WUPT), 0, scr, r, F.lane); continue; } r -= I_U;
        if (r < I_D) { transpose_item(F.w_down, DFF, DM, (bf16*)(F.ws + WS_WDNT), 0, scr, r, F.lane); continue; } r -= I_D;
        if (r < I_P) { transpose_item(F.w_pa, WA, DM, (bf16*)(F.ws + WS_WPA), 0, scr, r, F.lane); continue; } r -= I_P;
        if (r < I_P) { transpose_item(F.w_pb, WA, DM, (bf16*)(F.ws + WS_WPB), 0, scr, r, F.lane); continue; } r -= I_P;
        transpose_item(F.w_out, DM, DM, (bf16*)(F.ws + WS_WOUT), 0, scr, r, F.lane);
    }
}

#define MFMA32(a, b, c) __builtin_amdgcn_mfma_f32_32x32x16_bf16((a), (b), (c), 0, 0, 0)
constexpr int AP = 288;
constexpr int ATT_WAVE_LDS = 2 * 32 * AP;
constexpr float NEGF = -1e30f;
typedef __bf16 bf16x2_t __attribute__((ext_vector_type(2)));
typedef float f32x2_t __attribute__((ext_vector_type(2)));
typedef short v4i16_t __attribute__((ext_vector_type(4)));
__device__ __forceinline__ unsigned cvtpk(float lo, float hi) { f32x2_t v = {lo, hi}; bf16x2_t b = __builtin_convertvector(v, bf16x2_t); return __builtin_bit_cast(unsigned, b); }
__device__ __forceinline__ v4i16_t vtr(const LAS unsigned char* p) { return __builtin_amdgcn_ds_read_tr16_b64_v4i16((LAS v4i16_t*)p); }
__device__ __forceinline__ int pi32(int m) { return (m & 0x13) | ((m & 4) << 1) | ((m & 8) >> 1); }

struct AttnAcc { f32x16 o[4]; float m, l; };
__device__ __forceinline__ void attn_init(AttnAcc& A) {
#pragma unroll
    for (int dt = 0; dt < 4; ++dt)
#pragma unroll
        for (int r = 0; r < 16; ++r) A.o[dt][r] = 0.f;
    A.m = NEGF; A.l = 0.f;
}
__device__ __forceinline__ float attn_finish(AttnAcc& A, bf16* dst, size_t rowoff  , int lane) {
    const int hi = lane >> 5;
    const float lt = A.l + __shfl_xor(A.l, 32);
    const float inv = 1.0f / lt;
#pragma unroll
    for (int dt = 0; dt < 4; ++dt)
#pragma unroll
        for (int g4 = 0; g4 < 4; ++g4) { v2u w; w.x = cvtpk(A.o[dt][4 * g4 + 0] * inv, A.o[dt][4 * g4 + 1] * inv); w.y = cvtpk(A.o[dt][4 * g4 + 2] * inv, A.o[dt][4 * g4 + 3] * inv);
            *(v2u*)(dst + rowoff + 32 * dt + 8 * g4 + 4 * hi) = w; }
    return A.m + __builtin_amdgcn_logf(lt);
}

template <bool ISB> __device__ __forceinline__ void attn_unit(Frame& F, int u, LAS unsigned char* wl) {
    const bf16* QKV = (const bf16*)(F.ws + WS_QKV);
    const int lane = F.lane, q = lane & 31, hi = lane >> 5, lrow = lane >> 4, chunk = lane & 15;
    LAS unsigned char* kimg = wl; LAS unsigned char* vimg = wl + 32 * AP;
    constexpr int NT = ISB ? 16 : 5;
    const float c1 = 0.08838834764831845f * LOG2E;
    int b, h, d = 1, r = 0, L = SEQ, i0 = 0, R = 0, rs = 0, cq = 0, cs = 0, hb = 0; float slope2 = 0.f; size_t qrow;
    if (ISB) { b = u / 512; const int rem = u % 512; hb = rem >> 7; const int rem2 = rem & 127; R = rem2 >> 1; h = 12 + hb; cq = 32 * (rem2 & 1) + q; qrow = (size_t)b * SEQ + R * 64 + cq;
        rs = R - 4; rs = rs < 0 ? 0 : (rs > 56 ? 56 : rs); cs = cq - 8; cs = cs < 0 ? 0 : (cs > 48 ? 48 : cs); }
    else { b = u / 1536; const int rem = u % 1536; h = rem >> 7; const int idx = rem & 127, g = h >> 2, dsh = 2 * g, tpr = 128 >> dsh; d = 1 << dsh; L = SEQ >> dsh; r = idx / tpr; i0 = (idx % tpr) * 32;
        slope2 = exp2f(-8.0f * (float)(h + 1) / 12.0f) * (float)d * LOG2E; qrow = (size_t)b * SEQ + (size_t)(i0 + q) * d + r; }
    const int iq = i0 + q, jbase = i0 - 64;
    auto grow = [&](int t, int rl) -> unsigned {
        if (ISB) return (unsigned)(b * SEQ + (rs + (t >> 1)) * 64 + 32 * (t & 1) + rl) * (unsigned)NQKV;
        int j = jbase + 32 * t + rl; j = j < 0 ? 0 : (j > L - 1 ? L - 1 : j);
        return (unsigned)(b * SEQ + j * d + r) * (unsigned)NQKV; };
    bf16x8 qf[8];
#pragma unroll
    for (int st = 0; st < 8; ++st) qf[st] = *(const bf16x8*)(QKV + qrow * NQKV + h * 128 + 16 * st + 8 * hi);
    AttnAcc A; attn_init(A);
    const int kcol = 2048 + h * 128 + chunk * 8, vcol = 4096 + h * 128 + chunk * 8;
    v4u kreg[8], vreg[8]; unsigned ro[8];
#pragma unroll
    for (int i = 0; i < 8; ++i) { ro[i] = grow(0, lrow + 4 * i); kreg[i] = *(const v4u*)(QKV + ro[i] + kcol); }
    const float* rp = F.rpb + hb * (15 * 31);
    const LAS unsigned char* kfp = kimg + pi32(q) * AP + 16 * hi;
    const LAS unsigned char* vfp = vimg + (8 * hi + ((lane & 15) >> 2)) * AP + 32 * ((lane >> 4) & 1) + 8 * (lane & 3);
#pragma unroll 1
    for (int t = 0; t < NT; ++t) {
#pragma unroll
        for (int i = 0; i < 8; ++i) *(LAS v4u*)(kimg + (lrow + 4 * i) * AP + chunk * 16) = kreg[i];
#pragma unroll
        for (int i = 0; i < 8; ++i) vreg[i] = *(const v4u*)(QKV + ro[i] + vcol);
        if (t + 1 < NT) {
#pragma unroll
            for (int i = 0; i < 8; ++i) { ro[i] = grow(t + 1, lrow + 4 * i); kreg[i] = *(const v4u*)(QKV + ro[i] + kcol); }
        }
        LDS_WAIT();
        f32x16 s;
#pragma unroll
        for (int rr = 0; rr < 16; ++rr) s[rr] = 0.f;
#pragma unroll
        for (int st = 0; st < 8; ++st) { const bf16x8 kf = *(const LAS bf16x8*)(kfp + 32 * st); s = MFMA32(kf, qf[st], s); }
        float s2[16];
        if (ISB) {
            const int Rk = rs + (t >> 1), cb = 32 * (t & 1); const float* rpr = rp + (Rk - R + 7) * 31;
#pragma unroll
            for (int rr = 0; rr < 16; ++rr) { const int col = cb + 16 * (rr >> 3) + 8 * hi + (rr & 7); const bool valid = (col >= cs) && (col < cs + 16);
                int di = col - cq + 15; di = di < 0 ? 0 : (di > 30 ? 30 : di);
                s2[rr] = valid ? (s[rr] * c1 + rpr[di] * LOG2E) : NEGF; }
        } else {
#pragma unroll
            for (int rr = 0; rr < 16; ++rr) { const int j = jbase + 32 * t + 16 * (rr >> 3) + 8 * hi + (rr & 7); const int rel = j - iq, arel = rel < 0 ? -rel : rel;
                const bool valid = (arel <= 64) && (j >= 0) && (j < L);
                s2[rr] = valid ? (s[rr] * c1 - slope2 * (float)arel) : NEGF; }
        }
        float tmax = s2[0];
#pragma unroll
        for (int rr = 1; rr < 16; ++rr) tmax = fmaxf(tmax, s2[rr]);
        tmax = fmaxf(tmax, __shfl_xor(tmax, 32));
        const float mnew = fmaxf(A.m, tmax);
        const float alpha = __builtin_amdgcn_exp2f(A.m - mnew);
        A.m = mnew;
        float p[16]; float ps = 0.f;
#pragma unroll
        for (int rr = 0; rr < 16; ++rr) { p[rr] = (s2[rr] > -1e29f) ? __builtin_amdgcn_exp2f(s2[rr] - mnew) : 0.f; ps += p[rr]; }
        A.l = A.l * alpha + ps;
        if (__builtin_amdgcn_ballot_w64(alpha != 1.0f) != 0ull) {
#pragma unroll
            for (int dt = 0; dt < 4; ++dt) A.o[dt] = A.o[dt] * alpha;
        }
        bf16x8 pf[2];
#pragma unroll
        for (int sx = 0; sx < 2; ++sx) { v4u w; w.x = cvtpk(p[8 * sx + 0], p[8 * sx + 1]); w.y = cvtpk(p[8 * sx + 2], p[8 * sx + 3]); w.z = cvtpk(p[8 * sx + 4], p[8 * sx + 5]); w.w = cvtpk(p[8 * sx + 6], p[8 * sx + 7]); pf[sx] = __builtin_bit_cast(bf16x8, w); }
#pragma unroll
        for (int i = 0; i < 8; ++i) *(LAS v4u*)(vimg + (lrow + 4 * i) * AP + chunk * 16) = vreg[i];
        LDS_WAIT();
#pragma unroll
        for (int dt = 0; dt < 4; ++dt)
#pragma unroll
            for (int sx = 0; sx < 2; ++sx) {
                const v4i16_t lo = vtr(vfp + (16 * sx) * AP + 64 * dt), hi4 = vtr(vfp + (16 * sx + 4) * AP + 64 * dt);
                const bf16x8 vf = __builtin_shufflevector(lo, hi4, 0, 1, 2, 3, 4, 5, 6, 7);
                A.o[dt] = MFMA32(vf, pf[sx], A.o[dt]); }
        LDS_WAIT();
    }
    if (ISB) (void)attn_finish(A, (bf16*)(F.ws + WS_YB), qrow * 512 + hb * 128, lane);
    else { const float lse2 = attn_finish(A, (bf16*)(F.ws + WS_OA), qrow * 1536 + h * 128, lane); if (hi == 0) ((float*)(F.ws + WS_LSE))[qrow * 12 + h] = lse2; }
}
__device__ __forceinline__ void attn_phase(Frame& F) {
    LAS unsigned char* wl = F.lds + F.wave * ATT_WAVE_LDS;
    for (int su = F.gw; su < 2048; su += F.ngw) {
        if (su < 1024) attn_unit<true>(F, su, wl);
        else { const int a0 = 3 * (su - 1024); for (int k = 0; k < 3; ++k) attn_unit<false>(F, a0 + k, wl); }
    }
}
__device__ __forceinline__ void combine_phase(Frame& F) {
    const bf16* OA = (const bf16*)(F.ws + WS_OA); const float* LSE = (const float*)(F.ws + WS_LSE); bf16* YA = (bf16*)(F.ws + WS_YA);
    const int hg = F.lane >> 4, dc = (F.lane & 15) * 8;
    for (int m = F.gw; m < M; m += F.ngw) {
        const float l0 = LSE[(size_t)m * 12 + hg], l1 = LSE[(size_t)m * 12 + 4 + hg], l2 = LSE[(size_t)m * 12 + 8 + hg];
        const float mx = fmaxf(l0, fmaxf(l1, l2));
        float w0 = __builtin_amdgcn_exp2f(l0 - mx), w1 = __builtin_amdgcn_exp2f(l1 - mx), w2 = __builtin_amdgcn_exp2f(l2 - mx);
        const float inv = 1.0f / (w0 + w1 + w2); w0 *= inv; w1 *= inv; w2 *= inv;
        const v4u a = *(const v4u*)(OA + (size_t)m * 1536 + (0 + hg) * 128 + dc), bq = *(const v4u*)(OA + (size_t)m * 1536 + (4 + hg) * 128 + dc), c = *(const v4u*)(OA + (size_t)m * 1536 + (8 + hg) * 128 + dc);
        v4u o;
        o.x = pk2(w0 * bflo(a.x) + w1 * bflo(bq.x) + w2 * bflo(c.x), w0 * bfhi(a.x) + w1 * bfhi(bq.x) + w2 * bfhi(c.x));
        o.y = pk2(w0 * bflo(a.y) + w1 * bflo(bq.y) + w2 * bflo(c.y), w0 * bfhi(a.y) + w1 * bfhi(bq.y) + w2 * bfhi(c.y));
        o.z = pk2(w0 * bflo(a.z) + w1 * bflo(bq.z) + w2 * bflo(c.z), w0 * bfhi(a.z) + w1 * bfhi(bq.z) + w2 * bfhi(c.z));
        o.w = pk2(w0 * bflo(a.w) + w1 * bflo(bq.w) + w2 * bflo(c.w), w0 * bfhi(a.w) + w1 * bfhi(bq.w) + w2 * bfhi(c.w));
        *(v4u*)(YA + (size_t)m * 512 + hg * 128 + dc) = o;
    }
}
__device__ __forceinline__ void final_phase(Frame& F) {
    const float* SS2 = (const float*)(F.ws + WS_SS2);
    for (int m = F.gw; m < M; m += F.ngw) {
        const float rstd = 1.0f / sqrtf(__hip_atomic_load(SS2 + m, __ATOMIC_RELAXED, __HIP_MEMORY_SCOPE_AGENT) * (1.0f / DM) + EPS);
        f32x4* xr = (f32x4*)(F.out + (size_t)m * DM) + F.lane;
#pragma unroll
        for (int j = 0; j < 8; ++j) { const f32x4 g = ((const f32x4*)F.norm_final)[F.lane + 64 * j]; f32x4 v = xr[64 * j]; v = v * rstd * g; xr[64 * j] = v; }
    }
}

#define GAS __attribute__((address_space(1)))
#define XB_TMO      128
#define XB_XCNT(j)  (256  + 64 * (j))
#define XB_XSUB(j)  (1280 + 64 * (j))
#define XB_XGEN(j)  (2304 + 64 * (j))
#define XB_TOP      3328
#define XB_TOPGEN   3392
#define XCD_BAR_WORDS 3456
#define XB_SPIN_CAP (1u << 18)

__device__ __forceinline__ unsigned xb_ld(unsigned* p)              { return __hip_atomic_load(p, __ATOMIC_RELAXED, __HIP_MEMORY_SCOPE_AGENT); }
__device__ __forceinline__ unsigned xb_add(unsigned* p, unsigned v) { return __hip_atomic_fetch_add(p, v, __ATOMIC_RELAXED, __HIP_MEMORY_SCOPE_AGENT); }
__device__ __forceinline__ unsigned xb_xcc_id() { return (unsigned)__builtin_amdgcn_s_getreg((3 << 11) | 20) & 0xFu; }
#define XB_SPIN(cond, bar) do { unsigned _sp = 0; while (cond) { __builtin_amdgcn_s_sleep(1); \
    if ((++_sp & 255u) == 0u) { if (xb_ld(&(bar)[XB_TMO])) break; if (_sp > XB_SPIN_CAP) { atomicAdd(&(bar)[XB_TMO], 1u); break; } } } } while (0)

struct XcdBarrier {
    unsigned* bar; unsigned x;
    volatile LAS unsigned* st;
};

__device__ __forceinline__ XcdBarrier xcd_barrier_post(unsigned* bar, volatile LAS unsigned* st) {
    XcdBarrier b; b.bar = bar; b.x = xb_xcc_id(); b.st = st;
    if (threadIdx.x == 0) (void)xb_add(&bar[XB_XCNT(b.x)], 1u);
    return b;
}
__device__ __forceinline__ void xcd_barrier_complete(unsigned* bar, unsigned x, unsigned& nloc, unsigned& nx) {
    const unsigned G = gridDim.x * gridDim.y * gridDim.z;
    unsigned sum, cnt, mine, sp = 0u;
    for (;;) {
        sum = 0u; cnt = 0u; mine = 0u;
#pragma unroll
        for (unsigned j = 0; j < 16; ++j) { const unsigned c = xb_ld(&bar[XB_XCNT(j)]); sum += c; cnt += (c > 0u) ? 1u : 0u; mine = (j == x) ? c : mine; }
        if (sum == G) break;
        __builtin_amdgcn_s_sleep(1);
        if ((++sp & 255u) == 0u) { if (xb_ld(&bar[XB_TMO])) break; if (sp > XB_SPIN_CAP) { atomicAdd(&bar[XB_TMO], 1u); break; } }
    }
    nloc = mine > 0u ? mine : 1u; nx = cnt > 0u ? cnt : 1u;
}

__device__ __forceinline__ void xcd_barrier(const XcdBarrier& b) {
    asm volatile("s_waitcnt vmcnt(0)" ::: "memory");
    __syncthreads();
    if (threadIdx.x == 0) {
        unsigned* bar = b.bar;
        __builtin_amdgcn_s_waitcnt(0);
        unsigned nloc = b.st[0], nx = b.st[1];
        if (nloc == 0u) { xcd_barrier_complete(bar, b.x, nloc, nx); b.st[0] = nloc; b.st[1] = nx; }
        const unsigned old = xb_add(&bar[XB_XSUB(b.x)], 1u);
        const unsigned gen = old / nloc;
        if (old + 1u == (gen + 1u) * nloc) {
            __builtin_amdgcn_fence(__ATOMIC_RELEASE, "agent");
            asm volatile("s_waitcnt vmcnt(0)" ::: "memory");
            const unsigned og = xb_add(&bar[XB_TOP], 1u);
            const unsigned tg = og / nx;
            if (og + 1u == (tg + 1u) * nx) xb_add(&bar[XB_TOPGEN], 1u);
            else XB_SPIN(xb_ld(&bar[XB_TOPGEN]) == tg, bar);
            __builtin_amdgcn_fence(__ATOMIC_ACQUIRE, "agent");
            xb_add(&bar[XB_XGEN(b.x)], 1u);
            asm volatile("s_waitcnt vmcnt(0)" ::: "memory");
        } else {
            XB_SPIN(xb_ld(&bar[XB_XGEN(b.x)]) == gen, bar);
            __builtin_amdgcn_fence(__ATOMIC_ACQUIRE, "agent");
            asm volatile("s_waitcnt vmcnt(0)" ::: "memory");
        }
    }
    __syncthreads();
}

constexpr int NPHASE = 9;
struct Args { const float* in[13]; float* out; unsigned char* ws; int ph_lo, ph_hi, coop, pad; };
__global__ void __launch_bounds__(NWAVES * 64, 2) mega_fwd(Args args) {
    extern __shared__ __attribute__((aligned(16))) unsigned char lds[];
    cg::grid_group grid = cg::this_grid();
    Frame F;
    F.lds = (LAS unsigned char*)lds;
    F.tid = threadIdx.x; F.lane = F.tid & 63; F.wave = __builtin_amdgcn_readfirstlane(F.tid >> 6);
    F.G = gridDim.x; F.gw = blockIdx.x * NWAVES + F.wave; F.ngw = F.G * NWAVES;
    F.x = args.in[0]; F.norm_mix = args.in[1]; F.w_qkv = args.in[2]; F.w_gate = args.in[3]; F.b_gate = args.in[4]; F.rpb = args.in[5]; F.w_pa = args.in[6]; F.w_pb = args.in[7];
    F.w_out = args.in[8]; F.norm_mlp = args.in[9]; F.w_up = args.in[10]; F.w_down = args.in[11]; F.norm_final = args.in[12];
    F.out = args.out; F.ws = args.ws;
    const int lo = args.ph_lo, hi = args.ph_hi; const bool coop = args.coop != 0;
#define IN(k) (lo <= (k) && (k) < hi)
#define SEAM(k) do { if (coop && IN((k) + 1)) xcd_barrier(bar); else { asm volatile("s_waitcnt vmcnt(0) lgkmcnt(0)" ::: "memory"); __syncthreads(); } } while (0)
    volatile LAS unsigned* MISC = (volatile LAS unsigned*)(F.lds + MISC_OFF);
    for (int u = F.tid; u < 64; u += NWAVES * 64) MISC[u] = 0u;
    __syncthreads();
    XcdBarrier bar; bar.bar = (unsigned*)(args.ws + WS_CTL); bar.x = 0; bar.st = nullptr;
    if (coop) { bar = xcd_barrier_post((unsigned*)(args.ws + WS_CTL), MISC + 8); grid.sync(); }
    unsigned char* ws = args.ws;
    typedef pg8::bf16_t pb;
    if (IN(0)) { p0_prologue(F); SEAM(0); }
    if (IN(1)) {
        pg8::Gemm g{(const pb*)(ws + WS_H), (const pb*)(ws + WS_W1T), M, N1, DM}; pg8::StaticOrder S; S.init(M, N1, F.G, (int)blockIdx.x);
        pg8::EpiQkvGate E{(pb*)(ws + WS_QKV), (pb*)(ws + WS_G), F.b_gate};
        pg8::gemm_phase<pg8::EpiQkvGate, pg8::StaticOrder, true, true>(F.lds, g, S, E);
        SEAM(1);
    }
#ifdef PROBE_DOUBLE_P2
    if (IN(2)) { attn_phase(F); convert_updown(F); }
#endif
    if (IN(2)) { attn_phase(F); convert_updown(F); SEAM(2); }
    if (IN(3)) { combine_phase(F); SEAM(3); }
    if (IN(4)) {
        { pg8::Gemm g{(const pb*)(ws + WS_YB), (const pb*)(ws + WS_WPB), M, DM, WA}; pg8::StaticOrder S; S.init(M, DM, F.G, (int)blockIdx.x);
          pg8::EpiProj<true> E{(const pb*)(ws + WS_G), 2048, (pb*)(ws + WS_T), (pb*)(ws + WS_MG)};
          pg8::gemm_phase<pg8::EpiProj<true>, pg8::StaticOrder, true, true>(F.lds, g, S, E); }
        __syncthreads();
#ifndef PROBE_SKIP_PA
        { pg8::Gemm g{(const pb*)(ws + WS_YA), (const pb*)(ws + WS_WPA), M, DM, WA}; pg8::StaticOrder S; S.init(M, DM, F.G, (int)blockIdx.x);
          pg8::EpiProj<false> E{(const pb*)(ws + WS_G), 0, (pb*)(ws + WS_T), (pb*)(ws + WS_MG)};
          pg8::gemm_phase<pg8::EpiProj<false>, pg8::StaticOrder, true, true>(F.lds, g, S, E); }
#endif
        SEAM(4);
    }
    if (IN(5)) {
        pg8::Gemm g{(const pb*)(ws + WS_MG), (const pb*)(ws + WS_WOUT), M, DM, DM}; pg8::StaticOrder S; S.init(M, DM, F.G, (int)blockIdx.x);
        pg8::EpiOut E{F.x, F.out, (pb*)(ws + WS_XG2), F.norm_mlp, (float*)(ws + WS_SS1)};
        pg8::gemm_phase<pg8::EpiOut, pg8::StaticOrder, true, true>(F.lds, g, S, E);
        SEAM(5);
    }
    if (IN(6)) {
        pg8::Gemm g{(const pb*)(ws + WS_XG2), (const pb*)(ws + WS_WUPT), M, DFF, DM}; pg8::StaticOrder S; S.init(M, DFF, F.G, (int)blockIdx.x);
        pg8::EpiUp E{(pb*)(ws + WS_HM), (const float*)(ws + WS_SS1)};
        pg8::gemm_phase<pg8::EpiUp, pg8::StaticOrder, true, true>(F.lds, g, S, E);
        SEAM(6);
    }
    if (IN(7)) {
        pg8::Gemm g{(const pb*)(ws + WS_HM), (const pb*)(ws + WS_WDNT), M, DM, DFF}; pg8::StaticOrder S; S.init(M, DM, F.G, (int)blockIdx.x);
        pg8::EpiDown E{F.out, (float*)(ws + WS_SS2)};
        pg8::gemm_phase<pg8::EpiDown, pg8::StaticOrder, true, true>(F.lds, g, S, E);
        SEAM(7);
    }
    if (IN(8)) { final_phase(F); }
#undef IN
#undef SEAM
}

__global__ void dump_bf16(const unsigned short* src, float* dst, int n) { for (int i = blockIdx.x * blockDim.x + threadIdx.x; i < n; i += gridDim.x * blockDim.x) dst[i] = __uint_as_float((unsigned)src[i] << 16); }
#ifndef MK_N_LAUNCHES
#define MK_N_LAUNCHES 1
#endif
extern "C" void kernel_launch(void* const* d_in, const int* in_sizes, int n_in, void* d_out, int out_size, void* d_ws, size_t ws_size, hipStream_t stream) {
    static int grid = 0;
    if (grid == 0) {
        if (n_in != 13 || out_size != M * DM || ws_size < WS_END) { fprintf(stderr, "kernel_launch: unexpected shapes (n_in %d out %d ws %zu need %zu)\n", n_in, out_size, ws_size, (size_t)WS_END); grid = -1; return; }
        int dev = 0, cus = 0, per_cu = 0;
        hipGetDevice(&dev); hipDeviceGetAttribute(&cus, hipDeviceAttributeMultiprocessorCount, dev);
        hipFuncSetAttribute((const void*)mega_fwd, hipFuncAttributeMaxDynamicSharedMemorySize, LDS_BYTES);
        hipOccupancyMaxActiveBlocksPerMultiprocessor(&per_cu, (const void*)mega_fwd, NWAVES * 64, LDS_BYTES);
        (void)hipGetLastError();
        if (per_cu < 1) per_cu = 1;
        grid = cus;
    }
    if (grid < 0) return;
    Args a{};
    for (int i = 0; i < 13; ++i) a.in[i] = (const float*)d_in[i];
    a.out = (float*)d_out; a.ws = (unsigned char*)d_ws;
#if MK_N_LAUNCHES == 1
    if (hipMemsetAsync((char*)d_ws + WS_CTL, 0, CTL_ZERO_BYTES, stream) != hipSuccess) { fprintf(stderr, "memset failed\n"); return; }
    a.ph_lo = 0; a.ph_hi = NPHASE; a.coop = 1;
    void* kargs[] = {&a};
    hipError_t e = hipLaunchCooperativeKernel((const void*)mega_fwd, dim3(grid), dim3(NWAVES * 64), kargs, LDS_BYTES, stream);
    if (e != hipSuccess) fprintf(stderr, "cooperative launch failed: %s (grid %d)\n", hipGetErrorString(e), grid);
#else
#ifndef PROBE_STOP
#define PROBE_STOP NPHASE
#endif
    for (int p = 0; p < PROBE_STOP; ++p) {
        a.ph_lo = p; a.ph_hi = p + 1; a.coop = 0;
        hipLaunchKernelGGL(mega_fwd, dim3(grid), dim3(NWAVES * 64), LDS_BYTES, stream, a);
    }
#ifdef PROBE_DUMP_OFF
    hipLaunchKernelGGL(dump_bf16, dim3(2048), dim3(256), 0, stream, (const unsigned short*)((char*)d_ws + PROBE_DUMP_OFF), (float*)d_out, M * DM);
#endif
#endif
}
```
